# Optimizing an MI355X kernel written in HIP

```python
import math
import jax, jax.numpy as jnp
from jax import lax
import numpy as np

D_MODEL = 1024
BATCH = 16
SEQ = 2048
DEPTH = 4

HEAD_DIM = 64
EPS = 1e-6
NEG_INF = -1e30
A_HEADS = 8
A_BRANCHES = ((128, 1), (512, 4), (2048, 16))
T5_BUCKETS = 32
T5_MAX_DIST = 1024
B_HEADS = 8
B_Q_RANK = 768
B_KV_RANK = 256
B_NOPE = 64
B_ROPE = 32
B_V = 64
ROPE_BASE = 10000.0
ATTN_BLOCK = 128
C_GROUPS = 8
C_GROUP_W = 64
C_CHUNK = 128
C_WIDTH = C_GROUPS * C_GROUP_W
D_HEADS = 8
GRID_W = 64
NA_ROWS = 8
NA_COLS = 16
FFN_HIDDEN = -(-8 * D_MODEL // (3 * 256)) * 256
A_WIDTH = A_HEADS * HEAD_DIM
D_WIDTH = D_HEADS * HEAD_DIM
EVEN_IN = 3 * A_WIDTH + B_Q_RANK + B_KV_RANK + B_ROPE
EVEN_MIX = A_WIDTH + B_HEADS * B_V
ODD_IN = 2 * C_WIDTH + 3 * D_WIDTH
ODD_MIX = C_WIDTH + D_WIDTH
N_EVEN = (DEPTH + 1) // 2
N_ODD = DEPTH // 2

kernel_name = 'hybrid_dilated_mla_gmlp_natten_encoder'


def _rmsnorm(x, g):
    xf = x.astype(jnp.float32)
    y = xf * lax.rsqrt(jnp.mean(xf * xf, -1, keepdims=True) + EPS) * g.astype(jnp.float32)
    return y.astype(x.dtype)


def _t5_bucket(rel):
    nb = T5_BUCKETS // 2
    max_exact = nb // 2
    n = np.abs(rel)
    large = max_exact + (np.log(np.maximum(n, 1) / max_exact) / math.log(T5_MAX_DIST / max_exact) * (nb - max_exact)).astype(np.int64)
    large = np.minimum(large, nb - 1)
    return ((rel > 0) * nb + np.where(n < max_exact, n, large)).astype(np.int32)


def _dilated_branch(q, k, v, t5_table, window, dil):
    B, S, H, hd = q.shape
    half = (window // 2) // dil
    L = S // dil
    nb = -(-L // half)
    Lp = nb * half

    def sub(t):
        return t.reshape(B, L, dil, H, hd).transpose(0, 2, 1, 3, 4)

    qs = jnp.pad(sub(q), ((0, 0), (0, 0), (0, Lp - L), (0, 0), (0, 0))).reshape(B, dil, nb, half, H, hd)

    def win(t):
        tp = jnp.pad(sub(t), ((0, 0), (0, 0), (half, Lp - L + half), (0, 0), (0, 0))).reshape(B, dil, nb + 2, half, H, hd)
        return jnp.concatenate([tp[:, :, 0:nb], tp[:, :, 1:nb + 1], tp[:, :, 2:nb + 2]], axis=3)

    kw, vw = win(k), win(v)
    qi = np.arange(half)[:, None]
    kj = np.arange(3 * half)[None, :]
    off = kj - half - qi
    key_idx = np.arange(nb)[:, None, None] * half - half + kj[None]
    valid = (np.abs(off) <= half)[None] & (key_idx >= 0) & (key_idx < L)
    bias = jnp.transpose(t5_table[_t5_bucket(off * dil)], (2, 0, 1)).astype(jnp.float32)
    s = jnp.einsum('bgnqhd,bgnkhd->bgnhqk', qs, kw).astype(jnp.float32) * (hd ** -0.5) + bias
    s = jnp.where(valid[None, None, :, None], s, NEG_INF)
    m = jnp.max(s, -1, keepdims=True)
    p = jnp.exp(s - m)
    den = jnp.sum(p, -1)
    o = jnp.einsum('bgnhqk,bgnkhd->bgnqhd', p, vw.astype(jnp.float32)) / jnp.transpose(den, (0, 1, 2, 4, 3))[..., None]
    lse = m[..., 0] + jnp.log(den)
    o = o.reshape(B, dil, Lp, H, hd)[:, :, :L].transpose(0, 2, 1, 3, 4).reshape(B, S, H, hd)
    lse = jnp.transpose(lse, (0, 1, 2, 4, 3)).reshape(B, dil, Lp, H)[:, :, :L].transpose(0, 2, 1, 3).reshape(B, S, H)
    return o, lse


def _dilated_mixture(q, k, v, t5_table):
    B, S, H, hd = q.shape
    outs, lses = zip(*[_dilated_branch(q, k, v, t5_table, w, d) for (w, d) in A_BRANCHES])
    wts = jax.nn.softmax(jnp.stack(lses, 0), axis=0)
    o = jnp.sum(wts[..., None] * jnp.stack(outs, 0), 0)
    return o.astype(q.dtype).reshape(B, S, H * hd)


def _rope_tables(S):
    pos = jnp.arange(S, dtype=jnp.float32)
    inv = 1.0 / (ROPE_BASE ** (jnp.arange(0, B_ROPE, 2, dtype=jnp.float32) / B_ROPE))
    ang = pos[:, None] * inv[None, :]
    return jnp.cos(ang), jnp.sin(ang)


def _apply_rope(x, cos, sin):
    hf = B_ROPE // 2
    shape = (1, x.shape[1]) + (1,) * (x.ndim - 3) + (hf,)
    c, s = cos.reshape(shape), sin.reshape(shape)
    xf = x.astype(jnp.float32)
    x1, x2 = xf[..., :hf], xf[..., hf:]
    return jnp.concatenate([x1 * c - x2 * s, x1 * s + x2 * c], -1).astype(x.dtype)


def _mla(c_q, c_kv, k_pe, q_gain, kv_gain, w_uq, w_ukv, cos, sin):
    B, S, _ = c_q.shape
    q = (_rmsnorm(c_q, q_gain) @ w_uq).reshape(B, S, B_HEADS, B_NOPE + B_ROPE)
    kv = (_rmsnorm(c_kv, kv_gain) @ w_ukv).reshape(B, S, B_HEADS, B_NOPE + B_V)
    q = jnp.concatenate([q[..., :B_NOPE], _apply_rope(q[..., B_NOPE:], cos, sin)], -1)
    k_pe = _apply_rope(k_pe, cos, sin)
    k = jnp.concatenate([kv[..., :B_NOPE], jnp.broadcast_to(k_pe[:, :, None, :], (B, S, B_HEADS, B_ROPE))], -1)
    v = kv[..., B_NOPE:]
    scale = (B_NOPE + B_ROPE) ** -0.5
    nq = S // ATTN_BLOCK
    qb = q.reshape(B, nq, ATTN_BLOCK, B_HEADS, B_NOPE + B_ROPE).transpose(1, 0, 2, 3, 4)

    def block(qblk):
        s = jnp.einsum('bqhd,bkhd->bhqk', qblk, k).astype(jnp.float32) * scale
        p = jax.nn.softmax(s, -1)
        return jnp.einsum('bhqk,bkhd->bqhd', p, v.astype(jnp.float32)).astype(v.dtype)

    o = lax.map(block, qb)
    return o.transpose(1, 0, 2, 3, 4).reshape(B, S, B_HEADS * B_V)


def _spatial_gating(z_in, v_gain, w_s, b_s):
    B, S, _ = z_in.shape
    z = jax.nn.gelu(z_in.astype(jnp.float32))
    u, v = z[..., :C_WIDTH], z[..., C_WIDTH:]
    mu = jnp.mean(v, -1, keepdims=True)
    var = jnp.mean((v - mu) ** 2, -1, keepdims=True)
    vn = (v - mu) * lax.rsqrt(var + EPS) * v_gain.astype(jnp.float32)
    vc = vn.reshape(B, S // C_CHUNK, C_CHUNK, C_GROUPS, C_GROUP_W)
    sv = jnp.einsum('gij,bnjgc->bnigc', w_s.astype(jnp.float32), vc) + jnp.transpose(b_s.astype(jnp.float32))[None, None, :, :, None]
    return (u * sv.reshape(B, S, C_WIDTH)).astype(z_in.dtype)


def _neighbourhood_attention(q, k, v, rpb):
    B, S, H, hd = q.shape
    rows = S // GRID_W
    kr = min(NA_ROWS, rows)
    n_cb = GRID_W // NA_COLS
    kcw = 2 * NA_COLS
    qcol = np.arange(GRID_W).reshape(n_cb, NA_COLS)
    qstart = np.clip(qcol - NA_COLS // 2, 0, GRID_W - NA_COLS)
    kb_start = np.clip(np.arange(n_cb) * NA_COLS - NA_COLS // 2, 0, GRID_W - kcw)
    kcol = kb_start[:, None] + np.arange(kcw)[None, :]
    col_mask = (kcol[:, None, :] >= qstart[..., None]) & (kcol[:, None, :] < qstart[..., None] + NA_COLS)
    dc = np.clip(kcol[:, None, :] - qcol[..., None] + NA_COLS - 1, 0, 2 * NA_COLS - 2)
    qg = q.reshape(B, rows, GRID_W, H, hd)
    kg = k.reshape(B, rows, GRID_W, H, hd)
    vg = v.reshape(B, rows, GRID_W, H, hd)
    scale = hd ** -0.5

    def row_fn(args):
        qr, i = args
        r0 = jnp.clip(i - kr // 2, 0, rows - kr)
        krows = lax.dynamic_slice_in_dim(kg, r0, kr, axis=1)
        vrows = lax.dynamic_slice_in_dim(vg, r0, kr, axis=1)
        kblk = jnp.stack([krows[:, :, int(s0):int(s0) + kcw] for s0 in kb_start], axis=2)
        vblk = jnp.stack([vrows[:, :, int(s0):int(s0) + kcw] for s0 in kb_start], axis=2)
        qb = qr.reshape(B, n_cb, NA_COLS, H, hd)
        s = jnp.einsum('bcqhd,bacmhd->bhcqam', qb, kblk).astype(jnp.float32) * scale
        dr = r0 + jnp.arange(kr) - i + NA_ROWS - 1
        bias = rpb[:, dr[:, None, None, None], dc[None]].astype(jnp.float32)
        s = s + jnp.transpose(bias, (0, 2, 3, 1, 4))[None]
        s = jnp.where(col_mask[:, :, None, :], s, NEG_INF)
        p = jax.nn.softmax(s.reshape(B, H, n_cb, NA_COLS, kr * kcw), -1).reshape(s.shape)
        o = jnp.einsum('bhcqam,bacmhd->bcqhd', p, vblk.astype(jnp.float32))
        return o.reshape(B, GRID_W, H, hd).astype(q.dtype)

    out = lax.map(row_fn, (qg.transpose(1, 0, 2, 3, 4), jnp.arange(rows, dtype=jnp.int32)))
    return out.transpose(1, 0, 2, 3, 4).reshape(B, S, H * hd)


def setup_inputs(seed: int = 0) -> dict:
    key = jax.random.key(seed)
    ks = jax.random.split(key, 20)

    def nrm(k, shape, scale):
        return jax.random.normal(k, shape, jnp.float32) * scale

    def gain(k, shape):
        return 1.0 + 0.05 * jax.random.normal(k, shape, jnp.float32)

    return {
        'x': nrm(ks[0], (BATCH, SEQ, D_MODEL), 1.0),
        't5_bias': nrm(ks[1], (T5_BUCKETS, A_HEADS), 0.2),
        'norm_mix': gain(ks[2], (DEPTH, D_MODEL)),
        'norm_ffn': gain(ks[3], (DEPTH, D_MODEL)),
        'ev_w_in': nrm(ks[4], (N_EVEN, D_MODEL, EVEN_IN), D_MODEL ** -0.5),
        'ev_q_gain': gain(ks[5], (N_EVEN, B_Q_RANK)),
        'ev_kv_gain': gain(ks[6], (N_EVEN, B_KV_RANK)),
        'ev_w_uq': nrm(ks[7], (N_EVEN, B_Q_RANK, B_HEADS * (B_NOPE + B_ROPE)), B_Q_RANK ** -0.5),
        'ev_w_ukv': nrm(ks[8], (N_EVEN, B_KV_RANK, B_HEADS * (B_NOPE + B_V)), B_KV_RANK ** -0.5),
        'ev_w_out': nrm(ks[9], (N_EVEN, EVEN_MIX, D_MODEL), EVEN_MIX ** -0.5),
        'od_w_in': nrm(ks[10], (N_ODD, D_MODEL, ODD_IN), D_MODEL ** -0.5),
        'od_v_gain': gain(ks[11], (N_ODD, C_WIDTH)),
        'od_w_s': nrm(ks[12], (N_ODD, C_GROUPS, C_CHUNK, C_CHUNK), C_CHUNK ** -0.5),
        'od_b_s': nrm(ks[13], (N_ODD, C_GROUPS, C_CHUNK), 0.1),
        'od_rpb': nrm(ks[14], (N_ODD, D_HEADS, 2 * NA_ROWS - 1, 2 * NA_COLS - 1), 0.2),
        'od_w_out': nrm(ks[15], (N_ODD, ODD_MIX, D_MODEL), ODD_MIX ** -0.5),
        'ffn_w_gu': nrm(ks[16], (DEPTH, D_MODEL, 2 * FFN_HIDDEN), D_MODEL ** -0.5),
        'ffn_w_down': nrm(ks[17], (DEPTH, FFN_HIDDEN, D_MODEL), FFN_HIDDEN ** -0.5),
        'final_gain': gain(ks[18], (D_MODEL,)),
    }


def reference(x, t5_bias, norm_mix, norm_ffn, ev_w_in, ev_q_gain, ev_kv_gain, ev_w_uq, ev_w_ukv, ev_w_out,
              od_w_in, od_v_gain, od_w_s, od_b_s, od_rpb, od_w_out, ffn_w_gu, ffn_w_down, final_gain):
    B, S, _ = x.shape
    cos, sin = _rope_tables(S)
    for layer in range(DEPTH):
        h = _rmsnorm(x, norm_mix[layer])
        j = layer // 2
        if layer % 2 == 0:
            p = h @ ev_w_in[j]
            qa, ka, va = [p[..., i * A_WIDTH:(i + 1) * A_WIDTH].reshape(B, S, A_HEADS, HEAD_DIM) for i in range(3)]
            o0 = 3 * A_WIDTH
            o1 = o0 + B_Q_RANK
            o2 = o1 + B_KV_RANK
            a_out = _dilated_mixture(qa, ka, va, t5_bias)
            b_out = _mla(p[..., o0:o1], p[..., o1:o2], p[..., o2:o2 + B_ROPE], ev_q_gain[j], ev_kv_gain[j],
                         ev_w_uq[j], ev_w_ukv[j], cos, sin)
            x = x + jnp.concatenate([a_out, b_out], -1) @ ev_w_out[j]
        else:
            p = h @ od_w_in[j]
            c_out = _spatial_gating(p[..., :2 * C_WIDTH], od_v_gain[j], od_w_s[j], od_b_s[j])
            base = 2 * C_WIDTH
            qd, kd, vd = [p[..., base + i * D_WIDTH:base + (i + 1) * D_WIDTH].reshape(B, S, D_HEADS, HEAD_DIM) for i in range(3)]
            d_out = _neighbourhood_attention(qd, kd, vd, od_rpb[j])
            x = x + jnp.concatenate([c_out, d_out], -1) @ od_w_out[j]
        h = _rmsnorm(x, norm_ffn[layer])
        gu = h @ ffn_w_gu[layer]
        x = x + (jax.nn.silu(gu[..., :FFN_HIDDEN]) * gu[..., FFN_HIDDEN:]) @ ffn_w_down[layer]
    return _rmsnorm(x, final_gain)
```

```cpp
#include <hip/hip_runtime.h>
#include <hip/hip_cooperative_groups.h>
#include <cstdio>
#include <cstdint>
namespace cg = cooperative_groups;
__device__ __forceinline__ int otid() { int t = threadIdx.x; asm volatile("" : "+v"(t)); return t; }
__device__ __forceinline__ int obid() { int t = blockIdx.x; asm volatile("" : "+s"(t)); return t; }
namespace pg8 {
#define PG8_LAS __attribute__((address_space(3)))
typedef unsigned short bf16_t;
typedef short bf16x8 __attribute__((ext_vector_type(8)));
typedef float f32x4 __attribute__((ext_vector_type(4)));
typedef unsigned u32x4 __attribute__((ext_vector_type(4)));
constexpr int BM = 256, BK = 64, HALF = 128, HTB = HALF * BK * 2  , STAGE_BYTES = 8 * HTB, NXCD = 8, WGM = 8;

__host__ __device__ __forceinline__ int lds_byte(int r, int c) { const int st = (r >> 4) * 2 + (c >> 5), rr = r & 15, cc = c & 31, ob = rr * 64 + cc * 2; return st * 1024 + (ob ^ (((ob >> 9) & 1) << 5)); }
__host__ __device__ __forceinline__ void stage_rc(int b, int& R, int& C) { const int st = b / 1024, sb = b % 1024, swz = sb ^ (((sb >> 9) & 1) << 5); R = (st >> 1) * 16 + swz / 64; C = (st & 1) * 32 + (swz % 64) / 2; }
__host__ __device__ __forceinline__ int perm32(int rho) { const int n = rho >> 4, i = rho & 15; return 8 * (i >> 2) + 4 * n + (i & 3); }

struct Unit { int pm, pn; };
struct Gemm { const bf16_t* A; const bf16_t* Bt; int M, N, K; };

struct StaticOrder {
    int nM, nN, nwg, G, c;
    __host__ __device__ void init(int M, int N, int G_, int c_) { nM = M / BM; nN = N / BM; nwg = nM * nN; G = G_; c = c_; }
    __host__ __device__ bool next(int i, Unit& u) const {
        const long L = (long)i * G + c; if (L >= nwg) return false;
        int wgid = (int)L; { const int q = nwg / NXCD, r = nwg % NXCD, xcd = wgid % NXCD, off = wgid / NXCD; wgid = (xcd < r ? xcd * (q + 1) : r * (q + 1) + (xcd - r) * q) + off; }
        const int nig = WGM * nN, gid = wgid / nig, fm = gid * WGM, gsz = (nM - fm) < WGM ? (nM - fm) : WGM;
        u.pm = fm + ((wgid % nig) % gsz); u.pn = (wgid % nig) / gsz; return true;
    }
    __device__ __forceinline__ void a_ready(const Unit&) const {}
    __device__ __forceinline__ void done(const Unit&) const {}
};

__device__ __forceinline__ unsigned cvt_pk_bf16(float lo, float hi) { unsigned r; asm volatile("v_cvt_pk_bf16_f32 %0, %1, %2" : "=v"(r) : "v"(lo), "v"(hi)); return r; }
typedef float f32x2 __attribute__((ext_vector_type(2)));
template <class Epi, class Sched, bool ALIGN_EPI = false, bool SP2 = false>
__device__ __forceinline__ void gemm_phase(PG8_LAS unsigned char* lds, const Gemm g, const Sched& S, const Epi& E_in) {
    Epi E = E_in;
    const int tid = otid(), wid = __builtin_amdgcn_readfirstlane(tid >> 6), lane = tid & 63, wr = wid >> 2, wc = wid & 3, fr = lane & 15, fq = lane >> 4;
    const int K = g.K, nt = K / BK;
    unsigned voffA[2], voffB[2];
#pragma unroll
    for (int i = 0; i < 2; ++i) { int R, C; stage_rc(tid * 16 + i * 8192, R, C); const int Rb = Epi::PERM ? ((R & ~31) + perm32(R & 31)) : R;
        voffA[i] = (unsigned)(R * K + C) * 2u; voffB[i] = (unsigned)(Rb * K + C) * 2u; }
    const size_t kstep = (size_t)(BK * 2);
    const size_t hstep = (size_t)HALF * K * 2;
    const size_t tstep = 2 * hstep;
    const unsigned ldsw = (unsigned)wid * 1024u;
    const int aoff = lds_byte(wr * 64 + fr, fq * 8), boff = lds_byte(wc * 32 + fr, fq * 8);
#define PG8_SA(b, h) (((b) * 2 + (h)) * HTB)
#define PG8_SB(b, h) ((4 + (b) * 2 + (h)) * HTB)
#define PG8_STAGE(bufoff, gbase, voff) do { _Pragma("unroll") for (int _i = 0; _i < 2; ++_i) \
        __builtin_amdgcn_global_load_lds((const unsigned*)((const char*)(gbase) + (voff)[_i]), (PG8_LAS unsigned*)(lds + (bufoff) + ldsw + _i * 8192), 16, 0, 0); } while (0)
#define PG8_LDA(dst, b, h) do { _Pragma("unroll") for (int m = 0; m < 4; ++m) _Pragma("unroll") for (int k = 0; k < 2; ++k) dst[m][k] = *(const PG8_LAS bf16x8*)(lds + PG8_SA(b, h) + aoff + m * 2048 + k * 1024); } while (0)
#define PG8_LDB(dst, b, h) do { _Pragma("unroll") for (int n = 0; n < 2; ++n) _Pragma("unroll") for (int k = 0; k < 2; ++k) dst[n][k] = *(const PG8_LAS bf16x8*)(lds + PG8_SB(b, h) + boff + n * 2048 + k * 1024); } while (0)
#define PG8_MMA(ai, bj, At, Bt) do { __builtin_amdgcn_s_setprio(1); _Pragma("unroll") for (int m = 0; m < 4; ++m) _Pragma("unroll") for (int n = 0; n < 2; ++n) _Pragma("unroll") for (int k = 0; k < 2; ++k) \
        acc[ai][bj][m][n] = __builtin_amdgcn_mfma_f32_16x16x32_bf16(Bt[n][k], At[m][k], acc[ai][bj][m][n], 0, 0, 0); __builtin_amdgcn_s_setprio(0); } while (0)
#define PG8_WAIT_V(n) asm volatile("s_waitcnt vmcnt(" #n ")" ::: "memory")
#define PG8_WAIT_L(n) asm volatile("s_waitcnt lgkmcnt(" #n ")" ::: "memory")
#define PG8_BAR __builtin_amdgcn_s_barrier()
#define PG8_SCHED __builtin_amdgcn_sched_barrier(0)
    Unit cur, nxt; int ui = 0;
    if (!S.next(0, cur)) return;
    f32x4 acc[2][2][4][2];
#pragma unroll
    for (int a = 0; a < 2; ++a)
#pragma unroll
        for (int b = 0; b < 2; ++b)
#pragma unroll
            for (int m = 0; m < 4; ++m)
#pragma unroll
                for (int n = 0; n < 2; ++n) acc[a][b][m][n] = (f32x4){0.f, 0.f, 0.f, 0.f};
    bf16x8 At[4][2], B0[2][2], B1[2][2];
    const char* cA = (const char*)g.A + (size_t)cur.pm * tstep; const char* cB = (const char*)g.Bt + (size_t)cur.pn * tstep;
    S.a_ready(cur); E.pre(cur, wr, fr, fq);
    if constexpr (SP2) {
        PG8_STAGE(PG8_SB(0, 0), cB, voffB); PG8_STAGE(PG8_SB(0, 1), cB + hstep, voffB); PG8_STAGE(PG8_SA(0, 0), cA, voffA); PG8_STAGE(PG8_SA(0, 1), cA + hstep, voffA);
        if (wr == 1) PG8_BAR;
        PG8_WAIT_V(2); PG8_BAR;
        PG8_STAGE(PG8_SB(1, 0), cB + kstep, voffB); PG8_STAGE(PG8_SA(1, 0), cA + kstep, voffA); PG8_STAGE(PG8_SB(1, 1), cB + hstep + kstep, voffB);
        PG8_WAIT_V(6); PG8_BAR;
    } else {
        PG8_STAGE(PG8_SB(0, 0), cB, voffB); PG8_STAGE(PG8_SA(0, 0), cA, voffA); PG8_STAGE(PG8_SB(0, 1), cB + hstep, voffB); PG8_STAGE(PG8_SA(0, 1), cA + hstep, voffA);
        if (wr == 1) PG8_BAR;
        PG8_WAIT_V(4); PG8_BAR;
        PG8_STAGE(PG8_SB(1, 0), cB + kstep, voffB); PG8_STAGE(PG8_SA(1, 0), cA + kstep, voffA); PG8_STAGE(PG8_SB(1, 1), cB + hstep + kstep, voffB);
        PG8_WAIT_V(6); PG8_BAR;
    }
    for (;;) {
        const bool has_next = S.next(ui + 1, nxt);
        const char* nA = has_next ? (const char*)g.A + (size_t)nxt.pm * tstep : cA; const char* nB = has_next ? (const char*)g.Bt + (size_t)nxt.pn * tstep : cB;
        for (int t = 0; t < nt; t += 2) {
            const bool last = (t == nt - 2);
            const char* a1 = cA + (size_t)(t + 1) * kstep;
            const char* a2 = last ? nA : cA + (size_t)(t + 2) * kstep; const char* b2 = last ? nB : cB + (size_t)(t + 2) * kstep;
            const char* a3 = a2 + kstep; const char* b3 = b2 + kstep;
            if (last && has_next) S.a_ready(nxt);
            if constexpr (SP2) {
            PG8_LDB(B0, 0, 0); PG8_LDB(B1, 0, 1); PG8_SCHED; PG8_LDA(At, 0, 0); PG8_STAGE(PG8_SA(1, 1), a1 + hstep, voffA);
            PG8_WAIT_V(8); PG8_WAIT_L(0); PG8_BAR; PG8_MMA(0, 0, At, B0); PG8_MMA(0, 1, At, B1); PG8_BAR; PG8_SCHED;
            PG8_LDA(At, 0, 1); PG8_STAGE(PG8_SB(0, 0), b2, voffB); PG8_STAGE(PG8_SB(0, 1), b2 + hstep, voffB); PG8_STAGE(PG8_SA(0, 0), a2, voffA);
            PG8_WAIT_V(8); PG8_WAIT_L(0); PG8_BAR; PG8_MMA(1, 0, At, B0); PG8_MMA(1, 1, At, B1); PG8_BAR; PG8_SCHED;
            PG8_LDB(B0, 1, 0); PG8_LDB(B1, 1, 1); PG8_SCHED; PG8_LDA(At, 1, 0); PG8_STAGE(PG8_SA(0, 1), a2 + hstep, voffA);
            PG8_WAIT_V(8); PG8_WAIT_L(0); PG8_BAR; PG8_MMA(0, 0, At, B0); PG8_MMA(0, 1, At, B1); PG8_BAR; PG8_SCHED;
            PG8_LDA(At, 1, 1); PG8_STAGE(PG8_SB(1, 0), b3, voffB); PG8_STAGE(PG8_SB(1, 1), b3 + hstep, voffB); PG8_STAGE(PG8_SA(1, 0), a3, voffA);
            PG8_WAIT_V(8); PG8_WAIT_L(0); PG8_BAR; PG8_MMA(1, 0, At, B0); PG8_MMA(1, 1, At, B1); PG8_BAR; PG8_SCHED;
            } else {
            PG8_LDB(B0, 0, 0); PG8_SCHED; PG8_LDA(At, 0, 0); PG8_STAGE(PG8_SA(1, 1), a1 + hstep, voffA);
            PG8_WAIT_L(8); PG8_BAR; PG8_WAIT_L(0); PG8_MMA(0, 0, At, B0); PG8_BAR; PG8_SCHED;
            PG8_LDB(B1, 0, 1); PG8_STAGE(PG8_SB(0, 0), b2, voffB);
            PG8_BAR; PG8_WAIT_L(0); PG8_MMA(0, 1, At, B1); PG8_BAR;
            PG8_LDA(At, 0, 1); PG8_STAGE(PG8_SA(0, 0), a2, voffA);
            PG8_BAR; PG8_WAIT_L(0); PG8_MMA(1, 0, At, B0); PG8_BAR; PG8_SCHED;
            PG8_STAGE(PG8_SB(0, 1), b2 + hstep, voffB);
            PG8_WAIT_V(6); PG8_BAR; PG8_MMA(1, 1, At, B1); PG8_BAR;
            PG8_LDB(B0, 1, 0); PG8_SCHED; PG8_LDA(At, 1, 0); PG8_STAGE(PG8_SA(0, 1), a2 + hstep, voffA);
            PG8_WAIT_L(8); PG8_BAR; PG8_WAIT_L(0); PG8_MMA(0, 0, At, B0); PG8_BAR; PG8_SCHED;
            PG8_LDB(B1, 1, 1); PG8_STAGE(PG8_SB(1, 0), b3, voffB);
            PG8_BAR; PG8_WAIT_L(0); PG8_MMA(0, 1, At, B1); PG8_BAR;
            PG8_LDA(At, 1, 1); PG8_STAGE(PG8_SA(1, 0), a3, voffA);
            PG8_BAR; PG8_WAIT_L(0); PG8_MMA(1, 0, At, B0); PG8_BAR; PG8_SCHED;
            PG8_STAGE(PG8_SB(1, 1), b3 + hstep, voffB);
            PG8_WAIT_V(6); PG8_BAR; PG8_MMA(1, 1, At, B1); PG8_BAR;
            }
        }
        if constexpr (ALIGN_EPI) { if (wr == 0) PG8_BAR; }
        if constexpr (!Epi::AFTER_DRAIN) { E(acc, cur, wr, wc, fr, fq); S.done(cur); if (has_next) E.pre(nxt, wr, fr, fq); }
        if (!has_next) break;
#pragma unroll
        for (int a = 0; a < 2; ++a)
#pragma unroll
            for (int b = 0; b < 2; ++b)
#pragma unroll
                for (int m = 0; m < 4; ++m)
#pragma unroll
                    for (int n = 0; n < 2; ++n) acc[a][b][m][n] = (f32x4){0.f, 0.f, 0.f, 0.f};
        cur = nxt; cA = nA; cB = nB; ++ui;
        if constexpr (ALIGN_EPI) { if (wr == 1) PG8_BAR; }
    }
    PG8_WAIT_V(0);
    if constexpr (!ALIGN_EPI) { if (wr == 0) PG8_BAR; }
    PG8_BAR;
    if constexpr (Epi::AFTER_DRAIN) { E.fused(acc, cur, wr, wc, fr, fq, lds, wid, lane); S.done(cur); }
#undef PG8_SA
#undef PG8_SB
#undef PG8_STAGE
#undef PG8_LDA
#undef PG8_LDB
#undef PG8_MMA
#undef PG8_WAIT_V
#undef PG8_WAIT_L
#undef PG8_BAR
#undef PG8_SCHED
}
}

#define LAS __attribute__((address_space(3)))
typedef unsigned short bf16;
typedef short bf16x8 __attribute__((ext_vector_type(8)));
typedef short s16x4 __attribute__((ext_vector_type(4)));
typedef short v4i16_t __attribute__((ext_vector_type(4)));
typedef float f32x4 __attribute__((ext_vector_type(4)));
typedef float f32x2 __attribute__((ext_vector_type(2)));
typedef float f32x16 __attribute__((ext_vector_type(16)));
typedef unsigned u32x4 __attribute__((ext_vector_type(4)));
typedef unsigned u32x2 __attribute__((ext_vector_type(2)));
typedef __bf16 bf16x2_t __attribute__((ext_vector_type(2)));

constexpr int T = 32768, SEQ = 2048, NBATCH = 16, DM = 1024;
constexpr int EV_IN = 2592, EV_INP = 2816, OD_IN = 2560, FF = 2816;
constexpr float LOG2E = 1.4426950408889634f;
constexpr float EPS = 1e-6f;
constexpr float NEGBIG = -1e30f;

constexpr size_t MiB = 1u << 20;
constexpr size_t WS_ROPEC = 0, WS_ROPES = 128 * 1024;
constexpr size_t WS_SSA = 474 * MiB, WS_SSB = 476 * MiB;
constexpr size_t WS_BAR = 512 * 1024, BAR_BYTES = 16384;
constexpr size_t WS_W = 1 * MiB;
constexpr size_t E_EVIN = 0;
constexpr size_t E_UQ = E_EVIN + 2ull * EV_INP * 1024;
constexpr size_t E_UKV = E_UQ + 2ull * 768 * 768;
constexpr size_t E_EVOUT = E_UKV + 2ull * 1024 * 256;
constexpr size_t E_ODIN = E_EVOUT + 2ull * 1024 * 1024;
constexpr size_t E_ODOUT = E_ODIN + 2ull * OD_IN * 1024;
constexpr size_t E_GU = E_ODOUT + 2ull * 1024 * 1024;
constexpr size_t E_DN = E_GU + 4ull * 2 * FF * 1024;
constexpr size_t E_WS = E_DN + 4ull * 1024 * FF;
constexpr size_t E_END = E_WS + 2ull * 8 * 128 * 128;
static_assert(E_END * 2 <= 100 * MiB, "weights fit");
constexpr size_t WS_XN = 101 * MiB;
constexpr size_t WS_PH = 165 * MiB;
constexpr size_t WS_MIX = 341 * MiB;
constexpr size_t WS_KV = 405 * MiB;
constexpr size_t WS_KPE = 469 * MiB;
constexpr size_t WS_LSE = 471 * MiB;
constexpr size_t WS_QSS = 478 * MiB;
constexpr size_t WS_END = 480 * MiB;

constexpr int NWAVES = 8, NTHREADS = 512;
constexpr int LDS_BYTES = 147456, LDS_MISC = 140288;

#define RLX_AGENT __ATOMIC_RELAXED, __HIP_MEMORY_SCOPE_AGENT
#define XB_TMO      128
#define XB_XCNT(j)  (256  + 64 * (j))
#define XB_XSUB(j)  (1280 + 64 * (j))
#define XB_XGEN(j)  (2304 + 64 * (j))
#define XB_TOP      3328
#define XB_TOPGEN   3392
#define XCD_BAR_WORDS 3456
#define XB_SPIN_CAP (1u << 18)

__device__ __forceinline__ unsigned xb_ld(unsigned* p)              { return __hip_atomic_load(p, __ATOMIC_RELAXED, __HIP_MEMORY_SCOPE_AGENT); }
__device__ __forceinline__ unsigned xb_add(unsigned* p, unsigned v) { return __hip_atomic_fetch_add(p, v, __ATOMIC_RELAXED, __HIP_MEMORY_SCOPE_AGENT); }
__device__ __forceinline__ unsigned xb_xcc_id() { return (unsigned)__builtin_amdgcn_s_getreg((3 << 11) | 20) & 0xFu; }
#define XB_SPIN(cond, bar) do { unsigned _sp = 0; while (cond) { __builtin_amdgcn_s_sleep(1); \
    if ((++_sp & 255u) == 0u) { if (xb_ld(&(bar)[XB_TMO])) break; if (_sp > XB_SPIN_CAP) { atomicAdd(&(bar)[XB_TMO], 1u); break; } } } } while (0)

struct XcdBarrier {
    unsigned* bar; unsigned x;
    volatile LAS unsigned* st;
};

__device__ __forceinline__ XcdBarrier xcd_barrier_post(unsigned* bar, volatile LAS unsigned* st) {
    XcdBarrier b; b.bar = bar; b.x = xb_xcc_id(); b.st = st;
    if (threadIdx.x == 0) (void)xb_add(&bar[XB_XCNT(b.x)], 1u);
    return b;
}
__device__ __forceinline__ void xcd_barrier_complete(unsigned* bar, unsigned x, unsigned& nloc, unsigned& nx) {
    const unsigned G = gridDim.x * gridDim.y * gridDim.z;
    unsigned sum, cnt, mine, sp = 0u;
    for (;;) {
        sum = 0u; cnt = 0u; mine = 0u;
#pragma unroll
        for (unsigned j = 0; j < 16; ++j) { const unsigned c = xb_ld(&bar[XB_XCNT(j)]); sum += c; cnt += (c > 0u) ? 1u : 0u; mine = (j == x) ? c : mine; }
        if (sum == G) break;
        __builtin_amdgcn_s_sleep(1);
        if ((++sp & 255u) == 0u) { if (xb_ld(&bar[XB_TMO])) break; if (sp > XB_SPIN_CAP) { atomicAdd(&bar[XB_TMO], 1u); break; } }
    }
    nloc = mine > 0u ? mine : 1u; nx = cnt > 0u ? cnt : 1u;
}

__device__ __forceinline__ void xcd_barrier(const XcdBarrier& b) {
    asm volatile("s_waitcnt vmcnt(0)" ::: "memory");
    __syncthreads();
    if (threadIdx.x == 0) {
        unsigned* bar = b.bar;
        __builtin_amdgcn_s_waitcnt(0);
        unsigned nloc = b.st[0], nx = b.st[1];
        if (nloc == 0u) { xcd_barrier_complete(bar, b.x, nloc, nx); b.st[0] = nloc; b.st[1] = nx; }
        const unsigned old = xb_add(&bar[XB_XSUB(b.x)], 1u);
        const unsigned gen = old / nloc;
        if (old + 1u == (gen + 1u) * nloc) {
            __builtin_amdgcn_fence(__ATOMIC_RELEASE, "agent");
            asm volatile("s_waitcnt vmcnt(0)" ::: "memory");
            const unsigned og = xb_add(&bar[XB_TOP], 1u);
            const unsigned tg = og / nx;
            if (og + 1u == (tg + 1u) * nx) xb_add(&bar[XB_TOPGEN], 1u);
            else XB_SPIN(xb_ld(&bar[XB_TOPGEN]) == tg, bar);
            __builtin_amdgcn_fence(__ATOMIC_ACQUIRE, "agent");
            xb_add(&bar[XB_XGEN(b.x)], 1u);
            asm volatile("s_waitcnt vmcnt(0)" ::: "memory");
        } else {
            XB_SPIN(xb_ld(&bar[XB_XGEN(b.x)]) == gen, bar);
            __builtin_amdgcn_fence(__ATOMIC_ACQUIRE, "agent");
            asm volatile("s_waitcnt vmcnt(0)" ::: "memory");
        }
    }
    __syncthreads();
}

__device__ __forceinline__ float bf2f(unsigned short b) { return __uint_as_float((unsigned)b << 16); }
__device__ __forceinline__ unsigned pk2(float lo, float hi) { f32x2 v = {lo, hi}; bf16x2_t b = __builtin_convertvector(v, bf16x2_t); return __builtin_bit_cast(unsigned, b); }
__device__ __forceinline__ float shx(float v, int mask, int lane) { return __int_as_float(__builtin_amdgcn_ds_bpermute((lane ^ mask) << 2, __float_as_int(v))); }
__device__ __forceinline__ float shi(float v, int src) { return __int_as_float(__builtin_amdgcn_ds_bpermute(src << 2, __float_as_int(v))); }
__device__ __forceinline__ float wave_sum(float v, int lane) {
#pragma unroll
    for (int o = 1; o < 64; o <<= 1) v += shx(v, o, lane);
    return v;
}
__device__ __forceinline__ float fexp2(float x) { return __builtin_amdgcn_exp2f(x); }
__device__ __forceinline__ float frcp(float x) { return __builtin_amdgcn_rcpf(x); }
__device__ __forceinline__ float sigmoidf_(float z) { return frcp(1.0f + fexp2(-z * LOG2E)); }
__device__ __forceinline__ float silu_(float x) { return x * sigmoidf_(x); }
__device__ __forceinline__ float gelu_tanh_(float x) { return x * sigmoidf_(1.5957691216057308f * (x + 0.044715f * x * x * x)); }
__device__ __forceinline__ float row_rstd(const float* ss, int row) { const f32x4* p = (const f32x4*)(ss + (size_t)row * 16); const f32x4 a = p[0], b = p[1], c = p[2], d = p[3];
    const f32x4 t = (a + b) + (c + d); return rsqrtf(((t[0] + t[1]) + (t[2] + t[3])) * (1.f / DM) + EPS); }
__device__ __forceinline__ float row_rstd_m(const float* ss, int row, unsigned qmask, float sinv) { const f32x4* p = (const f32x4*)(ss + (size_t)row * 16); const f32x4 a = p[0], b = p[1], c = p[2], d = p[3];
    f32x4 t = {0.f, 0.f, 0.f, 0.f}; if (qmask & 1u) t += a; if (qmask & 2u) t += b; if (qmask & 4u) t += c; if (qmask & 8u) t += d; return rsqrtf(((t[0] + t[1]) + (t[2] + t[3])) * sinv + EPS); }
__device__ __forceinline__ int crow(int r, int hi) { return (r & 3) + 8 * (r >> 2) + 4 * hi; }
__device__ __forceinline__ s16x4 vtr(const LAS char* p) { return __builtin_bit_cast(s16x4, __builtin_amdgcn_ds_read_tr16_b64_v4i16((LAS v4i16_t*)p)); }
#define MFMA32(a, b, c) __builtin_amdgcn_mfma_f32_32x32x16_bf16((a), (b), (c), 0, 0, 0)
__device__ __forceinline__ bf16x8 pack8(const f32x16& x, int s) {
    u32x4 p; p.x = pk2(x[8 * s], x[8 * s + 1]); p.y = pk2(x[8 * s + 2], x[8 * s + 3]); p.z = pk2(x[8 * s + 4], x[8 * s + 5]); p.w = pk2(x[8 * s + 6], x[8 * s + 7]);
    return __builtin_bit_cast(bf16x8, p);
}

struct EpiUni {
    static constexpr bool PERM = true, AFTER_DRAIN = false;
    int mode; bf16* O; int ldc; const float* base; float* out; const float* ss_in; float* ss_out; bf16* xb;
    unsigned char* wsb; unsigned qmask; float sinv;
    float rs0, rs1;
    __device__ __forceinline__ void pre(const pg8::Unit& u, int wr, int fr, int fq) { rs0 = 1.f; rs1 = 1.f;
        if (ss_in) { const int r = u.pm * 256 + wr * 64 + fr + 16 * fq; rs0 = row_rstd_m(ss_in, r, qmask, sinv); rs1 = row_rstd_m(ss_in, r + 128, qmask, sinv); } }
    __device__ __forceinline__ void operator()(const pg8::f32x4 (&acc)[2][2][4][2], const pg8::Unit& u, int wr, int wc, int fr, int fq) const {
        const int row0 = u.pm * 256 + wr * 64 + fr;
        if (mode == 0 || mode == 3) {
            bf16* Ob = O; int ld = ldc; int col0 = u.pn * 256 + wc * 32 + 8 * fq; float* qs = nullptr; bool rope = false;
            unsigned char* wsl = wsb; asm volatile("" : "+s"(wsl));
            if (mode == 3 && u.pn >= 6) {
                if (u.pn < 9) { Ob = (bf16*)(wsl + WS_MIX); ld = 768; col0 -= 1536; qs = (float*)(wsl + WS_QSS) + (u.pn - 6) * 4 + wc; }
                else if (u.pn == 9) { Ob = (bf16*)(wsl + WS_MIX) + (size_t)T * 768; ld = 256; col0 -= 2304; qs = (float*)(wsl + WS_QSS) + 12 + wc; }
                else rope = true;
            }
            if (!rope) {
#pragma unroll
                for (int ai = 0; ai < 2; ++ai)
#pragma unroll
                    for (int m = 0; m < 4; ++m) { const int row = row0 + ai * 128 + m * 16; bf16* rowp = Ob + (size_t)row * ld + col0;
                        const float rs = shi(ai == 0 ? rs0 : rs1, fr + 16 * m); float q = 0.f;
#pragma unroll
                        for (int bj = 0; bj < 2; ++bj) { const pg8::f32x4 v0 = acc[ai][bj][m][0] * rs, v1 = acc[ai][bj][m][1] * rs;
                            u32x4 w; w.x = pk2(v0[0], v0[1]); w.y = pk2(v0[2], v0[3]); w.z = pk2(v1[0], v1[1]); w.w = pk2(v1[2], v1[3]);
                            *(u32x4*)(rowp + bj * 128) = w;
                            q += (v0[0] * v0[0] + v0[1] * v0[1]) + (v0[2] * v0[2] + v0[3] * v0[3]) + (v1[0] * v1[0] + v1[1] * v1[1]) + (v1[2] * v1[2] + v1[3] * v1[3]); }
                        if (qs) { q += shx(q, 16, fr + 16 * fq); q += shx(q, 32, fr + 16 * fq); if (fq == 0) qs[(size_t)row * 16] = q; } }
            } else if (wc == 0) {
                const float* rc = (const float*)(wsl + WS_ROPEC); const float* rsn = (const float*)(wsl + WS_ROPES); bf16* kpe = (bf16*)(wsl + WS_KPE);
                const int ln = fr + 16 * fq, i0 = 8 * (fq & 1);
#pragma unroll
                for (int ai = 0; ai < 2; ++ai)
#pragma unroll
                    for (int m = 0; m < 4; ++m) { const int row = row0 + ai * 128 + m * 16, pos = row & (SEQ - 1);
                        const float rs = shi(ai == 0 ? rs0 : rs1, fr + 16 * m);
                        const pg8::f32x4 v0 = acc[ai][0][m][0] * rs, v1 = acc[ai][0][m][1] * rs; pg8::f32x4 p0, p1;
#pragma unroll
                        for (int e = 0; e < 4; ++e) { p0[e] = shx(v0[e], 32, ln); p1[e] = shx(v1[e], 32, ln); }
                        const f32x4 c0 = *(const f32x4*)(rc + pos * 16 + i0), c1 = *(const f32x4*)(rc + pos * 16 + i0 + 4), s0 = *(const f32x4*)(rsn + pos * 16 + i0), s1 = *(const f32x4*)(rsn + pos * 16 + i0 + 4);
                        f32x4 o0, o1;
                        if (fq < 2) { o0 = v0 * c0 - p0 * s0; o1 = v1 * c1 - p1 * s1; } else { o0 = p0 * s0 + v0 * c0; o1 = p1 * s1 + v1 * c1; }
                        u32x4 w; w.x = pk2(o0[0], o0[1]); w.y = pk2(o0[2], o0[3]); w.z = pk2(o1[0], o1[1]); w.w = pk2(o1[2], o1[3]);
                        *(u32x4*)(kpe + (size_t)row * 32 + 8 * fq) = w; }
            }
        } else if (mode == 1) {
            const int col0 = u.pn * 128 + wc * 32 + 8 * fq;
#pragma unroll
            for (int ai = 0; ai < 2; ++ai)
#pragma unroll
                for (int m = 0; m < 4; ++m) { bf16* rowp = O + (size_t)(row0 + ai * 128 + m * 16) * FF + col0;
                    const float rs = shi(ai == 0 ? rs0 : rs1, fr + 16 * m);
                    const pg8::f32x4 g0 = acc[ai][0][m][0] * rs, g1 = acc[ai][0][m][1] * rs, u0 = acc[ai][1][m][0] * rs, u1 = acc[ai][1][m][1] * rs;
                    u32x4 w; w.x = pk2(silu_(g0[0]) * u0[0], silu_(g0[1]) * u0[1]); w.y = pk2(silu_(g0[2]) * u0[2], silu_(g0[3]) * u0[3]);
                    w.z = pk2(silu_(g1[0]) * u1[0], silu_(g1[1]) * u1[1]); w.w = pk2(silu_(g1[2]) * u1[2], silu_(g1[3]) * u1[3]);
                    *(u32x4*)rowp = w; }
        } else {
            const int col0 = u.pn * 256 + wc * 32 + 8 * fq;
#pragma unroll
            for (int ai = 0; ai < 2; ++ai) {
                u32x4 bb[4][2];
#pragma unroll
                for (int m = 0; m < 4; ++m) { const size_t off = (size_t)(row0 + ai * 128 + m * 16) * DM + col0;
#pragma unroll
                    for (int bj = 0; bj < 2; ++bj) bb[m][bj] = *(const u32x4*)(xb + off + bj * 128); }
                asm volatile("" ::: "memory");
#pragma unroll
                for (int m = 0; m < 4; ++m) { const size_t off = (size_t)(row0 + ai * 128 + m * 16) * DM + col0; float q = 0.f;
#pragma unroll
                    for (int bj = 0; bj < 2; ++bj) { const u32x4 b = bb[m][bj];
                        const f32x4 b0 = {__uint_as_float(b.x << 16), __uint_as_float(b.x & 0xffff0000u), __uint_as_float(b.y << 16), __uint_as_float(b.y & 0xffff0000u)};
                        const f32x4 b1 = {__uint_as_float(b.z << 16), __uint_as_float(b.z & 0xffff0000u), __uint_as_float(b.w << 16), __uint_as_float(b.w & 0xffff0000u)};
                        const f32x4 x0 = b0 + acc[ai][bj][m][0], x1 = b1 + acc[ai][bj][m][1];
                        u32x4 w; w.x = pk2(x0[0], x0[1]); w.y = pk2(x0[2], x0[3]); w.z = pk2(x1[0], x1[1]); w.w = pk2(x1[2], x1[3]);
                        *(u32x4*)(xb + off + bj * 128) = w;
                        q += (x0[0] * x0[0] + x0[1] * x0[1]) + (x0[2] * x0[2] + x0[3] * x0[3]) + (x1[0] * x1[0] + x1[1] * x1[1]) + (x1[2] * x1[2] + x1[3] * x1[3]); }
                    q += shx(q, 16, fr + 16 * fq); q += shx(q, 32, fr + 16 * fq);
                    if (fq == 0) ss_out[(size_t)(row0 + ai * 128 + m * 16) * 16 + u.pn * 4 + wc] = q; }
                asm volatile("" ::: "memory");
            }
        }
    }
};

struct ConvDesc { const float* W; int K, N; bf16* WT; int mode; const float* kscale; int cs_lo, cs_hi; float cs_val; };
__device__ __forceinline__ int maprow(int mode, int n) { if (mode == 1) { const int half = n >= FF ? 1 : 0, nn = n - half * FF; return 256 * (nn >> 7) + 128 * half + (nn & 127); } return n; }
__device__ __forceinline__ void conv_matrix(const ConvDesc& d, LAS float* scr, int gw, int ngw, int lane) {
    const int nblk = d.N / 32, nitems = (d.K / 64) * nblk;
    for (int item = gw; item < nitems; item += ngw) {
        const int kb = item / nblk, nb = item % nblk, k0 = 64 * kb, n0 = 32 * nb;
        const float cs = (n0 >= d.cs_lo && n0 < d.cs_hi) ? d.cs_val : 1.0f;
        scr[64 * 33 + lane] = d.kscale ? d.kscale[k0 + lane] : 1.0f;
#pragma unroll 8
        for (int i = 0; i < 32; ++i) { const int kk = 2 * i + (lane >> 5); scr[kk * 33 + (lane & 31)] = d.W[(size_t)(k0 + kk) * d.N + n0 + (lane & 31)] * (cs * scr[64 * 33 + kk]); }
        const int c = lane & 7;
#pragma unroll
        for (int j = 0; j < 4; ++j) { const int n = (lane >> 3) + 8 * j; const LAS float* s = scr + (8 * c) * 33 + n;
            u32x4 o; o.x = pk2(s[0 * 33], s[1 * 33]); o.y = pk2(s[2 * 33], s[3 * 33]); o.z = pk2(s[4 * 33], s[5 * 33]); o.w = pk2(s[6 * 33], s[7 * 33]);
            *(u32x4*)(d.WT + (size_t)maprow(d.mode, n0 + n) * d.K + k0 + 8 * c) = o; }
    }
}

struct Args { const float* in[19]; float* out; unsigned char* ws; int ph_lo, ph_hi; };
enum { I_X = 0, I_T5, I_NMIX, I_NFFN, I_EVWIN, I_EVQG, I_EVKVG, I_EVWUQ, I_EVWUKV, I_EVWOUT, I_ODWIN, I_ODVG, I_ODWS, I_ODBS, I_ODRPB, I_ODWOUT, I_FFNGU, I_FFNDN, I_FINAL };

typedef const __attribute__((address_space(4))) Args* ArgsP;
__device__ __forceinline__ void prologue(ArgsP ap, LAS unsigned char* lds, int wave, int lane) {
    bf16* Wb = (bf16*)(ap->ws + WS_W);
    LAS float* scr = (LAS float*)(lds + wave * 16384);
    const int gw = obid() * NWAVES + wave, ngw = gridDim.x * NWAVES;
    const float SA = 0.125f * LOG2E, SB = 0.10206207261596575f * LOG2E;
    for (int j = 0; j < 2; ++j) {
        { ConvDesc d{ap->in[I_EVWIN] + (size_t)j * 1024 * EV_IN, 1024, EV_IN, Wb + E_EVIN + (size_t)j * EV_INP * 1024, 0, ap->in[I_NMIX] + (2 * j) * DM, 0, 512, SA}; conv_matrix(d, scr, gw, ngw, lane); }
        { ConvDesc d{ap->in[I_EVWUQ] + (size_t)j * 768 * 768, 768, 768, Wb + E_UQ + (size_t)j * 768 * 768, 0, ap->in[I_EVQG] + j * 768, 0, 768, SB}; conv_matrix(d, scr, gw, ngw, lane); }
        { ConvDesc d{ap->in[I_EVWUKV] + (size_t)j * 256 * 1024, 256, 1024, Wb + E_UKV + (size_t)j * 1024 * 256, 0, ap->in[I_EVKVG] + j * 256, 0, 0, 1.f}; conv_matrix(d, scr, gw, ngw, lane); }
        { ConvDesc d{ap->in[I_EVWOUT] + (size_t)j * 1024 * 1024, 1024, 1024, Wb + E_EVOUT + (size_t)j * 1024 * 1024, 0, nullptr, 0, 0, 1.f}; conv_matrix(d, scr, gw, ngw, lane); }
        { ConvDesc d{ap->in[I_ODWIN] + (size_t)j * 1024 * OD_IN, 1024, OD_IN, Wb + E_ODIN + (size_t)j * OD_IN * 1024, 0, ap->in[I_NMIX] + (2 * j + 1) * DM, 1024, 1536, SA}; conv_matrix(d, scr, gw, ngw, lane); }
        { ConvDesc d{ap->in[I_ODWOUT] + (size_t)j * 1024 * 1024, 1024, 1024, Wb + E_ODOUT + (size_t)j * 1024 * 1024, 0, nullptr, 0, 0, 1.f}; conv_matrix(d, scr, gw, ngw, lane); }
    }
    for (int l = 0; l < 4; ++l) {
        { ConvDesc d{ap->in[I_FFNGU] + (size_t)l * 1024 * 2 * FF, 1024, 2 * FF, Wb + E_GU + (size_t)l * 2 * FF * 1024, 1, ap->in[I_NFFN] + l * DM, 0, 0, 1.f}; conv_matrix(d, scr, gw, ngw, lane); }
        { ConvDesc d{ap->in[I_FFNDN] + (size_t)l * FF * 1024, FF, 1024, Wb + E_DN + (size_t)l * 1024 * FF, 0, nullptr, 0, 0, 1.f}; conv_matrix(d, scr, gw, ngw, lane); }
    }
    { bf16* XB = (bf16*)(ap->ws + WS_XN); float* SSA = (float*)(ap->ws + WS_SSA); const float* X0 = ap->in[I_X];
#pragma unroll 4
      for (int row = gw; row < T; row += ngw) {
          const f32x4* xr = (const f32x4*)(X0 + (size_t)row * DM) + lane; f32x4 v[4]; float sq = 0.f;
#pragma unroll
          for (int jj = 0; jj < 4; ++jj) { v[jj] = xr[64 * jj]; sq += (v[jj].x * v[jj].x + v[jj].y * v[jj].y) + (v[jj].z * v[jj].z + v[jj].w * v[jj].w); }
          sq = wave_sum(sq, lane); if (lane < 16) SSA[(size_t)row * 16 + lane] = lane == 0 ? sq : 0.f;
          u32x2* o = (u32x2*)(XB + (size_t)row * DM) + lane;
#pragma unroll
          for (int jj = 0; jj < 4; ++jj) { u32x2 w; w.x = pk2(v[jj].x, v[jj].y); w.y = pk2(v[jj].z, v[jj].w); o[64 * jj] = w; } } }
    const int gt = obid() * NTHREADS + otid(), ngt = gridDim.x * NTHREADS;
    for (int j = 0; j < 2; ++j) { u32x4* z = (u32x4*)(Wb + E_EVIN + (size_t)j * EV_INP * 1024 + (size_t)EV_IN * 1024); unsigned z0 = 0u; asm volatile("" : "+v"(z0)); for (int i = gt; i < (EV_INP - EV_IN) * 1024 / 8; i += ngt) z[i] = (u32x4){z0, z0, z0, z0}; }
    { const float* ws = ap->in[I_ODWS]; unsigned* o = (unsigned*)(Wb + E_WS); for (int i = gt; i < 2 * 8 * 128 * 128 / 2; i += ngt) o[i] = pk2(ws[2 * i], ws[2 * i + 1]); }
    { float* rc = (float*)(ap->ws + WS_ROPEC); float* rs = (float*)(ap->ws + WS_ROPES);
      for (int i = gt; i < 2048 * 16; i += ngt) { const int pos = i >> 4, k = i & 15; const float inv = 1.0f / powf(10000.0f, (float)(2 * k) / 32.0f); const float ang = (float)pos * inv;
          double rev = (double)ang * 0.15915494309189535; rev -= rint(rev); const float fr = (float)rev; rc[i] = __builtin_amdgcn_cosf(fr); rs[i] = __builtin_amdgcn_sinf(fr); } }
}

__device__ __forceinline__ void rmsnorm_phase(const float* X, const float* g, bf16* XN, int wave, int lane) {
    const int gw = obid() * NWAVES + wave, ngw = gridDim.x * NWAVES;
    f32x4 gv[4];
#pragma unroll
    for (int j = 0; j < 4; ++j) gv[j] = ((const f32x4*)g)[lane + 64 * j];
    for (int row = gw; row < T; row += ngw) {
        const f32x4* xr = (const f32x4*)(X + (size_t)row * DM) + lane; f32x4 v[4]; float s = 0.f;
#pragma unroll
        for (int j = 0; j < 4; ++j) { v[j] = xr[64 * j]; s += (v[j].x * v[j].x + v[j].y * v[j].y) + (v[j].z * v[j].z + v[j].w * v[j].w); }
        const float rstd = rsqrtf(wave_sum(s, lane) * (1.f / DM) + EPS);
        u32x2* o = (u32x2*)(XN + (size_t)row * DM) + lane;
#pragma unroll
        for (int j = 0; j < 4; ++j) { u32x2 w; w.x = pk2(v[j].x * rstd * gv[j].x, v[j].y * rstd * gv[j].y); w.y = pk2(v[j].z * rstd * gv[j].z, v[j].w * rstd * gv[j].w); o[64 * j] = w; }
    }
}
__device__ __forceinline__ void final_norm_phase(float* out, const bf16* XB, const float* g, const float* ss, int wave, int lane) {
    const int gw = obid() * NWAVES + wave, ngw = gridDim.x * NWAVES;
    f32x4 gv[4];
#pragma unroll
    for (int j = 0; j < 4; ++j) gv[j] = ((const f32x4*)g)[lane + 64 * j];
#pragma unroll 4
    for (int row = gw; row < T; row += ngw) {
        const u32x2* xr = (const u32x2*)(XB + (size_t)row * DM) + lane; f32x4* orow = (f32x4*)(out + (size_t)row * DM) + lane; u32x2 v[4];
#pragma unroll
        for (int j = 0; j < 4; ++j) v[j] = xr[64 * j];
        const float rstd = row_rstd(ss, row);
#pragma unroll
        for (int j = 0; j < 4; ++j) { const f32x4 x = {__uint_as_float(v[j].x << 16), __uint_as_float(v[j].x & 0xffff0000u), __uint_as_float(v[j].y << 16), __uint_as_float(v[j].y & 0xffff0000u)};
            orow[64 * j] = x * rstd * gv[j]; }
    }
}
__device__ __forceinline__ void mla_prep_phase(const bf16* P, bf16* CQN, bf16* CKVN, bf16* KPE, const float* ropeC, const float* ropeS, int wave, int lane) {
    const int gw = obid() * NWAVES + wave, ngw = gridDim.x * NWAVES;
#pragma unroll 4
    for (int row = gw; row < T; row += ngw) {
        const bf16* pr = P + (size_t)row * EV_INP;
        u32x2 q[3]; float f[12]; float s = 0.f;
#pragma unroll
        for (int j = 0; j < 3; ++j) { q[j] = *((const u32x2*)(pr + 1536 + 256 * j) + lane);
            f[4 * j] = __uint_as_float(q[j].x << 16); f[4 * j + 1] = __uint_as_float(q[j].x & 0xffff0000u); f[4 * j + 2] = __uint_as_float(q[j].y << 16); f[4 * j + 3] = __uint_as_float(q[j].y & 0xffff0000u); }
#pragma unroll
        for (int i = 0; i < 12; ++i) s += f[i] * f[i];
        const float rq = rsqrtf(wave_sum(s, lane) * (1.f / 768.f) + EPS);
#pragma unroll
        for (int j = 0; j < 3; ++j) { u32x2 w; w.x = pk2(f[4 * j] * rq, f[4 * j + 1] * rq); w.y = pk2(f[4 * j + 2] * rq, f[4 * j + 3] * rq); *((u32x2*)(CQN + (size_t)row * 768 + 256 * j) + lane) = w; }
        const u32x2 kv = *((const u32x2*)(pr + 2304) + lane);
        const float k0 = __uint_as_float(kv.x << 16), k1 = __uint_as_float(kv.x & 0xffff0000u), k2 = __uint_as_float(kv.y << 16), k3 = __uint_as_float(kv.y & 0xffff0000u);
        const float rk = rsqrtf(wave_sum((k0 * k0 + k1 * k1) + (k2 * k2 + k3 * k3), lane) * (1.f / 256.f) + EPS);
        { u32x2 w; w.x = pk2(k0 * rk, k1 * rk); w.y = pk2(k2 * rk, k3 * rk); *((u32x2*)(CKVN + (size_t)row * 256) + lane) = w; }
        if (lane < 16) { const int pos = row & (SEQ - 1); const float c = ropeC[pos * 16 + lane], sn = ropeS[pos * 16 + lane];
            const float x1 = bf2f(pr[2560 + lane]), x2 = bf2f(pr[2560 + 16 + lane]);
            KPE[(size_t)row * 32 + lane] = (bf16)(pk2(x1 * c - x2 * sn, 0.f) & 0xffffu); KPE[(size_t)row * 32 + 16 + lane] = (bf16)(pk2(x1 * sn + x2 * c, 0.f) & 0xffffu); }
    }
}

template <int NS, int RSV> __device__ __forceinline__ void pv_acc(f32x16 (&o)[2], const bf16x8 (&pb)[NS], const LAS char* vt, int lane) {
    const int g = lane >> 4, hi = g >> 1;
    const int swz = (lane >> 3) & 1;
    const LAS char* base = vt + (4 * hi + ((lane & 15) >> 2)) * RSV + (16 * (g & 1) + 4 * (lane & 3)) * 2;
    const LAS char* bsel[2] = {base + swz * 64, base + (1 - swz) * 64};
#pragma unroll
    for (int db = 0; db < 2; ++db)
#pragma unroll
        for (int s = 0; s < NS; ++s) {
            const s16x4 lo = vtr(bsel[db] + (16 * s) * RSV), h4 = vtr(bsel[db] + (16 * s + 8) * RSV);
            const bf16x8 vf = {lo[0], lo[1], lo[2], lo[3], h4[0], h4[1], h4[2], h4[3]};
            o[db] = MFMA32(vf, pb[s], o[db]);
        }
}
template <int NS, int RSV> __device__ __forceinline__ void pv_acc_batched(f32x16 (&o)[2], const bf16x8 (&pb)[NS], const LAS char* vt, int lane) {
    const int g = lane >> 4, hi = g >> 1; const int swz = (lane >> 3) & 1;
    const LAS char* base = vt + (4 * hi + ((lane & 15) >> 2)) * RSV + (16 * (g & 1) + 4 * (lane & 3)) * 2;
    const LAS char* bsel[2] = {base + swz * 64, base + (1 - swz) * 64};
#pragma unroll
    for (int db = 0; db < 2; ++db) {
        bf16x8 vf[NS];
        __builtin_amdgcn_sched_barrier(0);
#pragma unroll
        for (int s = 0; s < NS; ++s) { const s16x4 lo = vtr(bsel[db] + (16 * s) * RSV), h4 = vtr(bsel[db] + (16 * s + 8) * RSV);
            vf[s] = (bf16x8){lo[0], lo[1], lo[2], lo[3], h4[0], h4[1], h4[2], h4[3]}; }
        __builtin_amdgcn_sched_barrier(0);
#pragma unroll
        for (int s = 0; s < NS; ++s) o[db] = MFMA32(vf[s], pb[s], o[db]);
    }
    __builtin_amdgcn_sched_barrier(0);
}
template <int NT> __device__ __forceinline__ void softmax_step(f32x16 (&s)[NT], float& m, float& l, f32x16 (&o)[2], bf16x8 (&pb)[2 * NT], int lane) {
    float tm = s[0][0];
#pragma unroll
    for (int t = 0; t < NT; ++t)
#pragma unroll
        for (int r = 0; r < 16; ++r) tm = fmaxf(tm, s[t][r]);
    tm = fmaxf(tm, shx(tm, 32, lane));
    if (__any(tm > m + 8.0f)) {
        const float mn = fmaxf(m, tm), alpha = fexp2(m - mn); m = mn; l *= alpha;
#pragma unroll
        for (int r = 0; r < 16; ++r) { o[0][r] *= alpha; o[1][r] *= alpha; }
    }
    float ps = 0.f;
#pragma unroll
    for (int t = 0; t < NT; ++t)
#pragma unroll
        for (int r = 0; r < 16; ++r) { s[t][r] = fexp2(s[t][r] - m); ps += s[t][r]; }
    l += ps;
#pragma unroll
    for (int t = 0; t < NT; ++t) { pb[2 * t] = pack8(s[t], 0); pb[2 * t + 1] = pack8(s[t], 1); }
}
__device__ __forceinline__ void store_o(const f32x16 (&o)[2], float inv, bf16* dst, int hi) {
#pragma unroll
    for (int db = 0; db < 2; ++db)
#pragma unroll
        for (int g4 = 0; g4 < 4; ++g4) { u32x2 w; w.x = pk2(o[db][4 * g4] * inv, o[db][4 * g4 + 1] * inv); w.y = pk2(o[db][4 * g4 + 2] * inv, o[db][4 * g4 + 3] * inv);
            *(u32x2*)(dst + 32 * db + 8 * g4 + 4 * hi) = w; }
}

constexpr int MLA_KRS = 208, MLA_KB = 64 * MLA_KRS, MLA_VB = 64 * 128, MLA_SLOT = MLA_KB + MLA_VB;
constexpr float MLA_THR = 8.0f;
constexpr int MLA_NS = 5;
__device__ __forceinline__ void glds16s(const void* sbase, unsigned voff, unsigned lds_dst) { unsigned keep;
    asm volatile("s_mov_b32 %0, m0\n\ts_mov_b32 m0, %3\n\ts_nop 0\n\tglobal_load_lds_dwordx4 %1, %2\n\ts_mov_b32 m0, %0" : "=&s"(keep) : "v"(voff), "s"(sbase), "s"(lds_dst) : "memory"); }
__device__ __forceinline__ void glds16(const void* gsrc, unsigned lds_dst) { unsigned keep;
    asm volatile("s_mov_b32 %0, m0\n\ts_mov_b32 m0, %2\n\ts_nop 0\n\tglobal_load_lds_dwordx4 %1, off\n\ts_mov_b32 m0, %0" : "=&s"(keep) : "v"(gsrc), "s"(lds_dst) : "memory"); }
__device__ __forceinline__ float fadd_s(float a, float b) { float r; asm("v_add_f32_e32 %0, %1, %2" : "=v"(r) : "v"(a), "v"(b)); return r; }
__device__ __forceinline__ float fsub_s(float a, float b) { float r; asm("v_sub_f32_e32 %0, %1, %2" : "=v"(r) : "v"(a), "v"(b)); return r; }
__device__ __forceinline__ void mla_qk(f32x16 (&s)[2], const LAS char* kslot, const bf16x8 (&qf)[6], int r32, int hi) {
    const LAS char* kb = kslot + r32 * MLA_KRS + 16 * hi;
#pragma unroll
    for (int d0 = 0; d0 < 6; ++d0) { const bf16x8 k0 = *(const LAS bf16x8*)(kb + 32 * d0), k1 = *(const LAS bf16x8*)(kb + 32 * MLA_KRS + 32 * d0);
        if (d0 == 0) { s[0] = MFMA32(k0, qf[0], (f32x16){}); s[1] = MFMA32(k1, qf[0], (f32x16){}); }
        else { s[0] = MFMA32(k0, qf[d0], s[0]); s[1] = MFMA32(k1, qf[d0], s[1]); } }
}
__device__ __forceinline__ void mla_softmax(f32x16 (&s)[2], float& m, float& l, f32x16 (&o)[2], bf16x8 (&pb)[4], int lane) {
    float ps0 = 0.f, ps1 = 0.f;
#pragma unroll
    for (int r = 0; r < 16; ++r) { s[0][r] = fexp2(fsub_s(s[0][r], m)); s[1][r] = fexp2(fsub_s(s[1][r], m)); }
#pragma unroll
    for (int r = 0; r < 16; ++r) { ps0 = fadd_s(ps0, s[0][r]); ps1 = fadd_s(ps1, s[1][r]); }
    float ps = fadd_s(ps0, ps1);
    if (__any(ps > 1048576.f)) {
        const float psm = fmaxf(ps, shx(ps, 32, lane)); const float dl = psm > 1048576.f ? __log2f(psm) : 0.f, f = fexp2(-dl);
        m += dl; l *= f; ps *= f;
#pragma unroll
        for (int r = 0; r < 16; ++r) { s[0][r] *= f; s[1][r] *= f; o[0][r] *= f; o[1][r] *= f; }
    }
    l += ps;
    pb[0] = pack8(s[0], 0); pb[1] = pack8(s[0], 1); pb[2] = pack8(s[1], 0); pb[3] = pack8(s[1], 1);
}
__device__ __forceinline__ void mla_unit(int b, int h, int qb, const bf16* P, const bf16* KV, const bf16* KPE, const float* ropeC, const float* ropeS, bf16* MIX, LAS char* lds, int wave, int lane) {
    const int tid = otid(), r32 = lane & 31, hi = lane >> 5;
    const int pos = qb * 256 + wave * 32 + r32; const size_t row = (size_t)b * SEQ + pos;
    bf16x8 qf[6];
    { const bf16* qp = P + row * EV_INP + 1536 + h * 96 + 8 * hi;
#pragma unroll
      for (int d0 = 0; d0 < 6; ++d0) qf[d0] = *(const bf16x8*)(qp + 16 * d0);
      bf16x8 x1 = qf[4], x2 = qf[5]; u32x4 o1, o2; float r1[8], r2[8];
#pragma unroll
      for (int j = 0; j < 8; ++j) { const float c = ropeC[pos * 16 + 8 * hi + j], sn = ropeS[pos * 16 + 8 * hi + j]; const float a1 = bf2f((unsigned short)x1[j]), a2 = bf2f((unsigned short)x2[j]); r1[j] = a1 * c - a2 * sn; r2[j] = a1 * sn + a2 * c; }
      o1.x = pk2(r1[0], r1[1]); o1.y = pk2(r1[2], r1[3]); o1.z = pk2(r1[4], r1[5]); o1.w = pk2(r1[6], r1[7]);
      o2.x = pk2(r2[0], r2[1]); o2.y = pk2(r2[2], r2[3]); o2.z = pk2(r2[4], r2[5]); o2.w = pk2(r2[6], r2[7]);
      qf[4] = __builtin_bit_cast(bf16x8, o1); qf[5] = __builtin_bit_cast(bf16x8, o2); }
    asm volatile("s_waitcnt vmcnt(0)" ::: "memory");
    const unsigned ldsb = (unsigned)(size_t)lds;
    const unsigned pe_base = (unsigned)((const char*)KPE - (const char*)KV);
    unsigned koff0, koff1, kstr0, kstr1, kd0, kd1;
    { const int p0 = wave, p1 = (wave + 8 < 13) ? wave + 8 : wave;
      { const int sl = p0 * 64 + lane, rw = sl / 13, c = sl - rw * 13;
        if (c >= 8 && c < 12) { koff0 = pe_base + (unsigned)(((b * SEQ + rw) * 32 + 8 * (c - 8)) * 2); kstr0 = 64 * 32 * 2; }
        else { koff0 = (unsigned)(((b * SEQ + rw) * 1024 + h * 128 + 8 * (c == 12 ? 0 : c)) * 2); kstr0 = 64 * 1024 * 2; } kd0 = p0 * 1024; }
      { const int sl = p1 * 64 + lane, rw = sl / 13, c = sl - rw * 13;
        if (c >= 8 && c < 12) { koff1 = pe_base + (unsigned)(((b * SEQ + rw) * 32 + 8 * (c - 8)) * 2); kstr1 = 64 * 32 * 2; }
        else { koff1 = (unsigned)(((b * SEQ + rw) * 1024 + h * 128 + 8 * (c == 12 ? 0 : c)) * 2); kstr1 = 64 * 1024 * 2; } kd1 = p1 * 1024; } }
    unsigned voff; { const int sl = wave * 64 + lane, rw = sl >> 3, c = (sl & 7) ^ ((rw & 2) << 1); voff = (unsigned)(((b * SEQ + rw) * 1024 + h * 128 + 64 + 8 * c) * 2); }
#define MLA_ISSUE(t, slot) do { const unsigned sb_ = ldsb + (unsigned)(slot) * MLA_SLOT; \
        glds16s(KV, koff0 + (unsigned)(t) * kstr0, (unsigned)__builtin_amdgcn_readfirstlane(sb_ + kd0)); \
        glds16s(KV, koff1 + (unsigned)(t) * kstr1, (unsigned)__builtin_amdgcn_readfirstlane(sb_ + kd1)); \
        glds16s(KV, voff + (unsigned)(t) * (64 * 1024 * 2), (unsigned)__builtin_amdgcn_readfirstlane(sb_ + MLA_KB + wave * 1024)); } while (0)
#define MLA_WAITBAR(N) asm volatile("s_waitcnt vmcnt(" #N ") lgkmcnt(0)\n\ts_barrier" ::: "memory")
    MLA_ISSUE(0, 0); MLA_ISSUE(1, 1); MLA_ISSUE(2, 2); MLA_ISSUE(3, 3);
    MLA_WAITBAR(6);
    float m, l = 0.f; f32x16 o[2]; o[0] = f32x16{}; o[1] = f32x16{};
    f32x16 sa[2], sb[2]; bf16x8 pb[4];
    mla_qk(sa, lds, qf, r32, hi);
    { float tm = sa[0][0];
#pragma unroll
      for (int r = 0; r < 16; ++r) tm = fmaxf(tm, fmaxf(sa[0][r], sa[1][r]));
      m = fmaxf(tm, shx(tm, 32, lane)); }
    int s0 = 0;
#define MLA_STEP(t, SC, SX) do { \
        const int s1 = (s0 == MLA_NS - 1) ? 0 : s0 + 1, s4 = (s0 == 0) ? MLA_NS - 1 : s0 - 1; \
        if ((t) + 4 < 32) MLA_ISSUE((t) + 4, s4); \
        const LAS char* kn_slot = lds + s1 * MLA_SLOT; \
        if (wave < 4) { mla_qk(SX, kn_slot, qf, r32, hi); mla_softmax(SC, m, l, o, pb, lane); } \
        else { mla_softmax(SC, m, l, o, pb, lane); mla_qk(SX, kn_slot, qf, r32, hi); } \
        pv_acc<4, 128>(o, pb, lds + s0 * MLA_SLOT + MLA_KB, lane); \
        s0 = s1; \
        if ((t) + 4 < 32) MLA_WAITBAR(6); else MLA_WAITBAR(0); } while (0)
#pragma unroll 1
    for (int t = 0; t < 32; t += 2) { MLA_STEP(t, sa, sb); MLA_STEP(t + 1, sb, sa); }
#undef MLA_STEP
#undef MLA_ISSUE
#undef MLA_WAITBAR
    { const int l2 = otid() & 63; l += shx(l, 32, l2); const size_t row2 = (size_t)b * SEQ + qb * 256 + wave * 32 + (l2 & 31); store_o(o, frcp(l), MIX + row2 * 1024 + 512 + h * 64, l2 >> 5); }
}

__device__ __forceinline__ void mla_load_q(bf16x8 (&qf)[6], const bf16* P, size_t row, int pos, int h, int hi, const float* ropeC, const float* ropeS) {
    const bf16* qp = P + row * EV_INP + 1536 + h * 96 + 8 * hi;
#pragma unroll
    for (int d0 = 0; d0 < 6; ++d0) qf[d0] = *(const bf16x8*)(qp + 16 * d0);
    bf16x8 x1 = qf[4], x2 = qf[5]; u32x4 o1, o2; float r1[8], r2[8];
#pragma unroll
    for (int j = 0; j < 8; ++j) { const float c = ropeC[pos * 16 + 8 * hi + j], sn = ropeS[pos * 16 + 8 * hi + j]; const float a1 = bf2f((unsigned short)x1[j]), a2 = bf2f((unsigned short)x2[j]); r1[j] = a1 * c - a2 * sn; r2[j] = a1 * sn + a2 * c; }
    o1.x = pk2(r1[0], r1[1]); o1.y = pk2(r1[2], r1[3]); o1.z = pk2(r1[4], r1[5]); o1.w = pk2(r1[6], r1[7]);
    o2.x = pk2(r2[0], r2[1]); o2.y = pk2(r2[2], r2[3]); o2.z = pk2(r2[4], r2[5]); o2.w = pk2(r2[6], r2[7]);
    qf[4] = __builtin_bit_cast(bf16x8, o1); qf[5] = __builtin_bit_cast(bf16x8, o2);
}
__device__ __forceinline__ void mla_unit2(int b, int h, int qb2, const bf16* P, const bf16* KV, const bf16* KPE, const float* ropeC, const float* ropeS, bf16* MIX, LAS char* lds, int wave, int lane) {
    const int r32 = lane & 31, hi = lane >> 5;
    const int posA = qb2 * 512 + wave * 64 + r32, posB = posA + 32;
    bf16x8 qfA[6], qfB[6];
    mla_load_q(qfA, P, (size_t)b * SEQ + posA, posA, h, hi, ropeC, ropeS);
    mla_load_q(qfB, P, (size_t)b * SEQ + posB, posB, h, hi, ropeC, ropeS);
    asm volatile("s_waitcnt vmcnt(0)" ::: "memory");
    const unsigned ldsb = (unsigned)(size_t)lds;
    const unsigned pe_base = (unsigned)((const char*)KPE - (const char*)KV);
    unsigned koff0, koff1, kstr0, kstr1, kd0, kd1;
    { const int p0 = wave, p1 = (wave + 8 < 13) ? wave + 8 : wave;
      { const int sl = p0 * 64 + lane, rw = sl / 13, c = sl - rw * 13;
        if (c >= 8 && c < 12) { koff0 = pe_base + (unsigned)(((b * SEQ + rw) * 32 + 8 * (c - 8)) * 2); kstr0 = 64 * 32 * 2; }
        else { koff0 = (unsigned)(((b * SEQ + rw) * 1024 + h * 128 + 8 * (c == 12 ? 0 : c)) * 2); kstr0 = 64 * 1024 * 2; } kd0 = p0 * 1024; }
      { const int sl = p1 * 64 + lane, rw = sl / 13, c = sl - rw * 13;
        if (c >= 8 && c < 12) { koff1 = pe_base + (unsigned)(((b * SEQ + rw) * 32 + 8 * (c - 8)) * 2); kstr1 = 64 * 32 * 2; }
        else { koff1 = (unsigned)(((b * SEQ + rw) * 1024 + h * 128 + 8 * (c == 12 ? 0 : c)) * 2); kstr1 = 64 * 1024 * 2; } kd1 = p1 * 1024; } }
    unsigned voff; { const int sl = wave * 64 + lane, rw = sl >> 3, c = (sl & 7) ^ ((rw & 2) << 1); voff = (unsigned)(((b * SEQ + rw) * 1024 + h * 128 + 64 + 8 * c) * 2); }
#define MLA_ISSUE(t, slot) do { const unsigned sb_ = ldsb + (unsigned)(slot) * MLA_SLOT; \
        glds16s(KV, koff0 + (unsigned)(t) * kstr0, (unsigned)__builtin_amdgcn_readfirstlane(sb_ + kd0)); \
        glds16s(KV, koff1 + (unsigned)(t) * kstr1, (unsigned)__builtin_amdgcn_readfirstlane(sb_ + kd1)); \
        glds16s(KV, voff + (unsigned)(t) * (64 * 1024 * 2), (unsigned)__builtin_amdgcn_readfirstlane(sb_ + MLA_KB + wave * 1024)); } while (0)
#define MLA_WAITBAR(N) asm volatile("s_waitcnt vmcnt(" #N ") lgkmcnt(0)\n\ts_barrier" ::: "memory")
    MLA_ISSUE(0, 0); MLA_ISSUE(1, 1); MLA_ISSUE(2, 2); MLA_ISSUE(3, 3);
    MLA_WAITBAR(6);
    float mA = 0.f, lA = 0.f, mB = 0.f, lB = 0.f; f32x16 oA[2], oB[2]; oA[0] = f32x16{}; oA[1] = f32x16{}; oB[0] = f32x16{}; oB[1] = f32x16{};
    int s0 = 0;
    const int g = lane >> 4, swz = (lane >> 3) & 1;
#pragma unroll 1
    for (int t = 0; t < 32; ++t) {
        const int s1 = (s0 == MLA_NS - 1) ? 0 : s0 + 1, s4 = (s0 == 0) ? MLA_NS - 1 : s0 - 1;
        if (t + 4 < 32) MLA_ISSUE(t + 4, s4);
        const LAS char* kb = lds + s0 * MLA_SLOT + r32 * MLA_KRS + 16 * hi;
        f32x16 sA[2], sB[2];
#pragma unroll
        for (int d0 = 0; d0 < 6; ++d0) { const bf16x8 k0 = *(const LAS bf16x8*)(kb + 32 * d0), k1 = *(const LAS bf16x8*)(kb + 32 * MLA_KRS + 32 * d0);
            if (d0 == 0) { sA[0] = MFMA32(k0, qfA[0], (f32x16){}); sA[1] = MFMA32(k1, qfA[0], (f32x16){}); sB[0] = MFMA32(k0, qfB[0], (f32x16){}); sB[1] = MFMA32(k1, qfB[0], (f32x16){}); }
            else { sA[0] = MFMA32(k0, qfA[d0], sA[0]); sA[1] = MFMA32(k1, qfA[d0], sA[1]); sB[0] = MFMA32(k0, qfB[d0], sB[0]); sB[1] = MFMA32(k1, qfB[d0], sB[1]); } }
        if (t == 0) {
            float ta = sA[0][0], tb = sB[0][0];
#pragma unroll
            for (int r = 0; r < 16; ++r) { ta = fmaxf(ta, fmaxf(sA[0][r], sA[1][r])); tb = fmaxf(tb, fmaxf(sB[0][r], sB[1][r])); }
            mA = fmaxf(ta, shx(ta, 32, lane)); mB = fmaxf(tb, shx(tb, 32, lane)); }
        bf16x8 pbA[4], pbB[4];
        asm volatile("s_nop 15\n\ts_nop 7" : "+v"(sA[0]), "+v"(sA[1]), "+v"(sB[0]), "+v"(sB[1]));
        mla_softmax(sA, mA, lA, oA, pbA, lane);
        mla_softmax(sB, mB, lB, oB, pbB, lane);
        { const LAS char* vt = lds + s0 * MLA_SLOT + MLA_KB;
          const LAS char* base = vt + (4 * (g >> 1) + ((lane & 15) >> 2)) * 128 + (16 * (g & 1) + 4 * (lane & 3)) * 2;
          const LAS char* bsel[2] = {base + swz * 64, base + (1 - swz) * 64};
#pragma unroll
          for (int s = 0; s < 4; ++s)
#pragma unroll
              for (int db = 0; db < 2; ++db) { const s16x4 lo = vtr(bsel[db] + (16 * s) * 128), h4 = vtr(bsel[db] + (16 * s + 8) * 128);
                  const bf16x8 vf = {lo[0], lo[1], lo[2], lo[3], h4[0], h4[1], h4[2], h4[3]};
                  oA[db] = MFMA32(vf, pbA[s], oA[db]); oB[db] = MFMA32(vf, pbB[s], oB[db]); } }
        s0 = s1;
        if (t + 4 < 32) MLA_WAITBAR(6); else MLA_WAITBAR(0);
    }
#undef MLA_ISSUE
#undef MLA_WAITBAR
    { const int l2 = otid() & 63; const int h2 = l2 >> 5; lA += shx(lA, 32, l2); lB += shx(lB, 32, l2);
      const size_t rowA = (size_t)b * SEQ + qb2 * 512 + wave * 64 + (l2 & 31);
      store_o(oA, frcp(lA), MIX + rowA * 1024 + 512 + h * 64, h2); store_o(oB, frcp(lB), MIX + (rowA + 32) * 1024 + 512 + h * 64, h2); }
}

__device__ __forceinline__ float t5_bias_val(const float* t5, int h, int rel) {
    const int n = rel < 0 ? -rel : rel; int bk;
    if (n < 8) bk = n; else bk = 8 + (n >= 15) + (n >= 27) + (n >= 50) + (n >= 91) + (n >= 166) + (n >= 305) + (n >= 559);
    if (rel > 0) bk += 16;
    return t5[bk * 8 + h] * LOG2E;
}
__device__ __forceinline__ void aattn_task(int b, int h, int br, int dil, int r, int i0, const bf16* P, const LAS float* biasT, LAS char* vt, bf16* OB, int ldo, float* LSE, int lane) {
    const int r32 = lane & 31, hi = lane >> 5; const int L = SEQ / dil;
    const size_t qtok = (size_t)b * SEQ + (size_t)(i0 + r32) * dil + r;
    bf16x8 qf[4];
    { const bf16* qp = P + qtok * EV_INP + h * 64 + 8 * hi;
#pragma unroll
      for (int d0 = 0; d0 < 4; ++d0) qf[d0] = *(const bf16x8*)(qp + 16 * d0); }
    float m = NEGBIG, l = 0.f; f32x16 o[2]; o[0] = f32x16{}; o[1] = f32x16{};
    int list = 0, n = 0;
#pragma unroll
    for (int it = 0; it < 5; ++it) { const int kt = (it == 0) ? 2 : (it <= 2 ? it - 1 : it); const int kb_ = i0 - 64 + 32 * kt; if (kb_ + 31 >= 0 && kb_ < L) { list |= kt << (3 * n); ++n; } }
    bf16x8 kfN[4]; u32x4 vvN[4];
#define AA_LOAD(kt_) do { const int kbase_ = i0 - 64 + 32 * (kt_); int kc_ = kbase_ + r32; kc_ = kc_ < 0 ? 0 : (kc_ >= L ? L - 1 : kc_); \
        const bf16* kp_ = P + ((size_t)b * SEQ + (size_t)kc_ * dil + r) * EV_INP + 512 + h * 64 + 8 * hi; \
        _Pragma("unroll") for (int d0 = 0; d0 < 4; ++d0) kfN[d0] = *(const bf16x8*)(kp_ + 16 * d0); \
        _Pragma("unroll") for (int i = 0; i < 4; ++i) { const int c = lane + 64 * i, kk = c >> 3; int kx = kbase_ + kk; kx = kx < 0 ? 0 : (kx >= L ? L - 1 : kx); \
            vvN[i] = *(const u32x4*)(P + ((size_t)b * SEQ + (size_t)kx * dil + r) * EV_INP + 1024 + h * 64 + 8 * (c & 7)); } } while (0)
    AA_LOAD(list & 7);
#pragma unroll 1
    for (int it = 0; it < n; ++it) {
        const int kt = (list >> (3 * it)) & 7; const int kbase = i0 - 64 + 32 * kt;
        bf16x8 kf[4]; u32x4 vv[4];
#pragma unroll
        for (int i = 0; i < 4; ++i) { kf[i] = kfN[i]; vv[i] = vvN[i]; }
        if (it + 1 < n) AA_LOAD((list >> (3 * (it + 1))) & 7);
#pragma unroll
        for (int i = 0; i < 4; ++i) { const int c = lane + 64 * i; *(LAS u32x4*)(vt + (c >> 3) * 128 + (((c & 7) ^ (((c >> 3) & 2) << 1)) * 16)) = vv[i]; }
        f32x16 s[1]; s[0] = f32x16{};
#pragma unroll
        for (int d0 = 0; d0 < 4; ++d0) s[0] = MFMA32(kf[d0], qf[d0], s[0]);
        { const LAS float* bt = biasT + (32 * kt + 32 - r32 + 4 * hi);
          if (kbase >= 0 && kbase + 31 < L) {
#pragma unroll
              for (int rr = 0; rr < 16; ++rr) s[0][rr] += bt[(rr & 3) + 8 * (rr >> 2)];
          } else {
#pragma unroll
              for (int rr = 0; rr < 16; ++rr) { const int kidx = kbase + crow(rr, hi); s[0][rr] = (kidx >= 0 && kidx < L) ? s[0][rr] + bt[(rr & 3) + 8 * (rr >> 2)] : NEGBIG; }
          } }
        bf16x8 pb[2];
        softmax_step<1>(s, m, l, o, pb, lane);
        pv_acc<2, 128>(o, pb, vt, lane);
    }
#undef AA_LOAD
    l += shx(l, 32, lane);
    store_o(o, frcp(l), OB + qtok * ldo + h * 64, hi);
    if (hi == 0) LSE[((size_t)br * T + qtok) * 8 + h] = m + __log2f(l);
}
constexpr int AK_RS = 144;
__device__ __forceinline__ void aattn_task_lds(int b, int h, int br, int dil, int r, int i0, int lrow0, const bf16* P, const LAS float* biasT, const LAS char* Kl, const LAS char* Vl, bf16* OB, int ldo, const bf16* OB1r, float* LSE, int lane) {
    const int r32 = lane & 31, hi = lane >> 5; const int L = SEQ / dil;
    const size_t qtok = (size_t)b * SEQ + (size_t)(i0 + r32) * dil + r;
    bf16x8 qf[4];
    { const bf16* qp = P + qtok * EV_INP + h * 64 + 8 * hi;
#pragma unroll
      for (int d0 = 0; d0 < 4; ++d0) qf[d0] = *(const bf16x8*)(qp + 16 * d0); }
    float m = NEGBIG, l = 0.f; f32x16 o[2]; o[0] = f32x16{}; o[1] = f32x16{};
#pragma unroll 1
    for (int it = 0; it < 5; ++it) {
        const int kt = (it == 0) ? 2 : (it <= 2 ? it - 1 : it); const int kbase = i0 - 64 + 32 * kt;
        if (kbase + 31 < 0 || kbase >= L) continue;
        const int lrow = lrow0 + 32 * kt;
        const LAS char* kp = Kl + (lrow + r32) * AK_RS + 16 * hi;
        f32x16 s[1]; s[0] = f32x16{};
#pragma unroll
        for (int d0 = 0; d0 < 4; ++d0) { const bf16x8 kf = *(const LAS bf16x8*)(kp + 32 * d0); s[0] = MFMA32(kf, qf[d0], s[0]); }
        { const LAS float* bt = biasT + (32 * kt + 32 - r32 + 4 * hi);
          if (kbase >= 0 && kbase + 31 < L) {
#pragma unroll
              for (int rr = 0; rr < 16; ++rr) s[0][rr] += bt[(rr & 3) + 8 * (rr >> 2)];
          } else {
#pragma unroll
              for (int rr = 0; rr < 16; ++rr) { const int kidx = kbase + crow(rr, hi); s[0][rr] = (kidx >= 0 && kidx < L) ? s[0][rr] + bt[(rr & 3) + 8 * (rr >> 2)] : NEGBIG; }
          } }
        bf16x8 pb[2];
        softmax_step<1>(s, m, l, o, pb, lane);
        pv_acc<2, 128>(o, pb, Vl + lrow * 128, lane);
    }
    l += shx(l, 32, lane);
    if (br < 2) {
        store_o(o, frcp(l), OB + qtok * ldo + h * 64, hi);
        if (hi == 0) LSE[((size_t)br * T + qtok) * 8 + h] = m + __log2f(l);
    } else {
        const float l3 = m + __log2f(l), l1 = LSE[((size_t)0 * T + qtok) * 8 + h], l2 = LSE[((size_t)1 * T + qtok) * 8 + h];
        const float mx = fmaxf(l3, fmaxf(l1, l2)); float w1 = fexp2(l1 - mx), w2 = fexp2(l2 - mx), w3 = fexp2(l3 - mx); const float inv = frcp(w1 + w2 + w3); w1 *= inv; w2 *= inv; w3 *= inv * frcp(l);
        bf16* dst = OB + qtok * ldo + h * 64; const bf16* p2 = OB1r + qtok * 512 + h * 64;
        u32x2 av[2][4], bv[2][4];
#pragma unroll
        for (int db = 0; db < 2; ++db)
#pragma unroll
            for (int g4 = 0; g4 < 4; ++g4) { const int off = 32 * db + 8 * g4 + 4 * hi; av[db][g4] = *(const u32x2*)(dst + off); bv[db][g4] = *(const u32x2*)(p2 + off); }
#pragma unroll
        for (int db = 0; db < 2; ++db)
#pragma unroll
            for (int g4 = 0; g4 < 4; ++g4) { const int off = 32 * db + 8 * g4 + 4 * hi; const u32x2 a = av[db][g4], bq = bv[db][g4];
                const float e0 = w1 * __uint_as_float(a.x << 16) + w2 * __uint_as_float(bq.x << 16) + w3 * o[db][4 * g4];
                const float e1 = w1 * __uint_as_float(a.x & 0xffff0000u) + w2 * __uint_as_float(bq.x & 0xffff0000u) + w3 * o[db][4 * g4 + 1];
                const float e2 = w1 * __uint_as_float(a.y << 16) + w2 * __uint_as_float(bq.y << 16) + w3 * o[db][4 * g4 + 2];
                const float e3 = w1 * __uint_as_float(a.y & 0xffff0000u) + w2 * __uint_as_float(bq.y & 0xffff0000u) + w3 * o[db][4 * g4 + 3];
                u32x2 w; w.x = pk2(e0, e1); w.y = pk2(e2, e3); *(u32x2*)(dst + off) = w; }
    }
}
__device__ __forceinline__ void aattn_unit(int b, int h, int sb, const bf16* P, const float* t5, bf16* MIX, bf16* OB1, bf16* OB2, float* LSE, LAS char* lds, int wave, int lane) {
    LAS float* biasT = (LAS float*)lds;
    LAS char* Kl = lds + 4096; LAS char* Vl = Kl + 384 * AK_RS;
    for (int i = otid(); i < 3 * 192; i += NTHREADS) { const int br = i / 192, j = i % 192 - 96; const int dil = br == 0 ? 1 : (br == 1 ? 4 : 16); biasT[i] = (j >= -64 && j <= 64) ? t5_bias_val(t5, h, j * dil) : NEGBIG; }
#pragma unroll 1
    for (int g = 0; g < 14; ++g) {
        int br, dil, r0, nres, kb0, q0;
        if (g < 4) { br = 0; dil = 1; r0 = 0; nres = 1; q0 = 1024 * sb + 256 * g; kb0 = q0 - 64; }
        else if (g < 8) { br = 1; dil = 4; r0 = g - 4; nres = 1; q0 = 256 * sb; kb0 = q0 - 64; }
        else { br = 2; dil = 16; r0 = 3 * (g - 8); nres = (g == 13) ? 1 : 3; q0 = 64 * sb; kb0 = 0; }
        const int L = SEQ / dil; const int nrows = (br == 2) ? 128 * nres : 384;
        __syncthreads();
#pragma unroll 1
        for (int hb = 0; hb < 3; ++hb) { const int tid = otid(); u32x4 st[4];
#pragma unroll
          for (int i = 0; i < 4; ++i) { const int c = tid + NTHREADS * (4 * hb + i), row = c >> 4, part = c & 15;
              int kidx, rr_; if (br == 2) { rr_ = r0 + (row >> 7); kidx = row & 127; } else { rr_ = r0; kidx = kb0 + row; kidx = kidx < 0 ? 0 : (kidx >= L ? L - 1 : kidx); }
              const bf16* src = P + ((size_t)b * SEQ + (size_t)kidx * dil + rr_) * EV_INP + 512 + h * 64 + (part < 8 ? 8 * part : 512 + 8 * (part - 8));
              st[i] = (row < nrows) ? *(const u32x4*)src : (u32x4){0u, 0u, 0u, 0u}; }
#pragma unroll
          for (int i = 0; i < 4; ++i) { const int c = tid + NTHREADS * (4 * hb + i), row = c >> 4, part = c & 15;
              if (part < 8) *(LAS u32x4*)(Kl + row * AK_RS + part * 16) = st[i]; else *(LAS u32x4*)(Vl + row * 128 + (((part - 8) ^ ((row & 2) << 1)) * 16)) = st[i]; } }
        __syncthreads();
        bf16* OB = br == 1 ? OB1 : MIX; const int ldo = br == 1 ? 512 : 1024;
        if (br < 2) aattn_task_lds(b, h, br, dil, r0, q0 + 32 * wave, 32 * wave, P, biasT + br * 192, Kl, Vl, OB, ldo, OB1, LSE, lane);
        else if (wave < 2 * nres) { const int j = wave >> 1, i0 = q0 + 32 * (wave & 1); aattn_task_lds(b, h, br, dil, r0 + j, i0, 128 * j + i0 - 64, P, biasT + br * 192, Kl, Vl, OB, ldo, OB1, LSE, lane); }
    }
    __syncthreads();
}

__device__ __forceinline__ void natten_task(int b, int h, int ip, int cb, const bf16* P, const float* rpb, LAS float* rpbL, LAS char* vt, bf16* MIX, int lane) {
    const int r32 = lane & 31, hi = lane >> 5;
    for (int i = lane; i < 15 * 31; i += 64) rpbL[i] = rpb[h * 465 + i] * LOG2E;
    const int qi = 2 * ip + (r32 >> 4), qc = 16 * cb + (r32 & 15);
    const size_t qtok = (size_t)b * SEQ + qi * 64 + qc;
    bf16x8 qf[4];
    { const bf16* qp = P + qtok * OD_IN + 1024 + h * 64 + 8 * hi;
#pragma unroll
      for (int d0 = 0; d0 < 4; ++d0) qf[d0] = *(const bf16x8*)(qp + 16 * d0); }
    int r0q = qi - 4; r0q = r0q < 0 ? 0 : (r0q > 24 ? 24 : r0q);
    int qs = qc - 8; qs = qs < 0 ? 0 : (qs > 48 ? 48 : qs);
    int kb = 16 * cb - 8; kb = kb < 0 ? 0 : (kb > 32 ? 32 : kb);
    int rlo = 2 * ip - 4; rlo = rlo < 0 ? 0 : (rlo > 24 ? 24 : rlo);
    int rhi = 2 * ip + 1 - 4; rhi = (rhi < 0 ? 0 : (rhi > 24 ? 24 : rhi)) + 7;
    float m = NEGBIG, l = 0.f; f32x16 o[2]; o[0] = f32x16{}; o[1] = f32x16{};
    const int nrow = rhi - rlo + 1;
    bf16x8 kfN[4]; u32x4 vvN[4];
#define NA_ROW(it_) ((it_) == 0 ? 2 * ip : ((rlo + (it_) - 1 >= 2 * ip) ? rlo + (it_) : rlo + (it_) - 1))
#define NA_LOAD(kr_) do { const size_t kt0_ = (size_t)b * SEQ + (kr_) * 64 + kb; const bf16* kp_ = P + (kt0_ + r32) * OD_IN + 1536 + h * 64 + 8 * hi; \
        _Pragma("unroll") for (int d0 = 0; d0 < 4; ++d0) kfN[d0] = *(const bf16x8*)(kp_ + 16 * d0); \
        _Pragma("unroll") for (int i = 0; i < 4; ++i) { const int c = lane + 64 * i; vvN[i] = *(const u32x4*)(P + (kt0_ + (c >> 3)) * OD_IN + 2048 + h * 64 + 8 * (c & 7)); } } while (0)
    NA_LOAD(2 * ip);
#pragma unroll 1
    for (int it = 0; it < nrow; ++it) {
        const int kr = NA_ROW(it);
        bf16x8 kf[4]; u32x4 vv[4];
#pragma unroll
        for (int i = 0; i < 4; ++i) { kf[i] = kfN[i]; vv[i] = vvN[i]; }
        if (it + 1 < nrow) { const int krn = NA_ROW(it + 1); NA_LOAD(krn); }
#pragma unroll
        for (int i = 0; i < 4; ++i) { const int c = lane + 64 * i; *(LAS u32x4*)(vt + (c >> 3) * 128 + (((c & 7) ^ (((c >> 3) & 2) << 1)) * 16)) = vv[i]; }
        f32x16 s[1]; s[0] = f32x16{};
#pragma unroll
        for (int d0 = 0; d0 < 4; ++d0) s[0] = MFMA32(kf[d0], qf[d0], s[0]);
        const bool rowok = (kr >= r0q) && (kr < r0q + 8); const int dr = kr - qi + 7;
#pragma unroll
        for (int rr = 0; rr < 16; ++rr) { const int kcol = kb + crow(rr, hi); const bool valid = rowok && (kcol >= qs) && (kcol < qs + 16);
            int dc = kcol - qc + 15; dc = dc < 0 ? 0 : (dc > 30 ? 30 : dc); const int drc = dr < 0 ? 0 : (dr > 14 ? 14 : dr);
            s[0][rr] = valid ? s[0][rr] + rpbL[drc * 31 + dc] : NEGBIG; }
        bf16x8 pb[2];
        softmax_step<1>(s, m, l, o, pb, lane);
        pv_acc<2, 128>(o, pb, vt, lane);
    }
#undef NA_LOAD
#undef NA_ROW
    l += shx(l, 32, lane);
    store_o(o, frcp(l), MIX + qtok * 1024 + 512 + h * 64, hi);
}

__device__ __forceinline__ void natten_task2(int b, int h, int ipp, int cb, const bf16* P, const float* rpb, LAS float* rpbL, LAS char* vt, bf16* MIX, int lane) {
    const int r32 = lane & 31, hi = lane >> 5;
    for (int i = lane; i < 15 * 31; i += 64) rpbL[i] = rpb[h * 465 + i] * LOG2E;
    const int qiA = 4 * ipp + (r32 >> 4), qiB = qiA + 2, qc = 16 * cb + (r32 & 15);
    const size_t qtokA = (size_t)b * SEQ + qiA * 64 + qc, qtokB = qtokA + 128;
    bf16x8 qfA[4], qfB[4];
    { const bf16* qp = P + qtokA * OD_IN + 1024 + h * 64 + 8 * hi; const bf16* qq = P + qtokB * OD_IN + 1024 + h * 64 + 8 * hi;
#pragma unroll
      for (int d0 = 0; d0 < 4; ++d0) { qfA[d0] = *(const bf16x8*)(qp + 16 * d0); qfB[d0] = *(const bf16x8*)(qq + 16 * d0); } }
    int r0A = qiA - 4; r0A = r0A < 0 ? 0 : (r0A > 24 ? 24 : r0A);
    int r0B = qiB - 4; r0B = r0B < 0 ? 0 : (r0B > 24 ? 24 : r0B);
    int qs = qc - 8; qs = qs < 0 ? 0 : (qs > 48 ? 48 : qs);
    int kb = 16 * cb - 8; kb = kb < 0 ? 0 : (kb > 32 ? 32 : kb);
    int rlo = 4 * ipp - 4; rlo = rlo < 0 ? 0 : (rlo > 24 ? 24 : rlo);
    int rhi = 4 * ipp + 3 - 4; rhi = (rhi < 0 ? 0 : (rhi > 24 ? 24 : rhi)) + 7;
    const int first = 4 * ipp + 1;
    float mA = NEGBIG, lA = 0.f, mB = NEGBIG, lB = 0.f; f32x16 oA[2], oB[2]; oA[0] = f32x16{}; oA[1] = f32x16{}; oB[0] = f32x16{}; oB[1] = f32x16{};
    const int nrow = rhi - rlo + 1;
    bf16x8 kfN[4]; u32x4 vvN[4];
#define NA_ROW(it_) ((it_) == 0 ? first : ((rlo + (it_) - 1 >= first) ? rlo + (it_) : rlo + (it_) - 1))
#define NA_LOAD(kr_) do { const size_t kt0_ = (size_t)b * SEQ + (kr_) * 64 + kb; const bf16* kp_ = P + (kt0_ + r32) * OD_IN + 1536 + h * 64 + 8 * hi; \
        _Pragma("unroll") for (int d0 = 0; d0 < 4; ++d0) kfN[d0] = *(const bf16x8*)(kp_ + 16 * d0); \
        _Pragma("unroll") for (int i = 0; i < 4; ++i) { const int c = lane + 64 * i; vvN[i] = *(const u32x4*)(P + (kt0_ + (c >> 3)) * OD_IN + 2048 + h * 64 + 8 * (c & 7)); } } while (0)
    NA_LOAD(first);
    const int g = lane >> 4, swz = (lane >> 3) & 1;
    const LAS char* vbase = vt + (4 * (g >> 1) + ((lane & 15) >> 2)) * 128 + (16 * (g & 1) + 4 * (lane & 3)) * 2;
#pragma unroll 1
    for (int it = 0; it < nrow; ++it) {
        const int kr = NA_ROW(it);
        bf16x8 kf[4]; u32x4 vv[4];
#pragma unroll
        for (int i = 0; i < 4; ++i) { kf[i] = kfN[i]; vv[i] = vvN[i]; }
        if (it + 1 < nrow) { const int krn = NA_ROW(it + 1); NA_LOAD(krn); }
#pragma unroll
        for (int i = 0; i < 4; ++i) { const int c = lane + 64 * i; *(LAS u32x4*)(vt + (c >> 3) * 128 + (((c & 7) ^ (((c >> 3) & 2) << 1)) * 16)) = vv[i]; }
        f32x16 sA[1], sB[1]; sA[0] = f32x16{}; sB[0] = f32x16{};
#pragma unroll
        for (int d0 = 0; d0 < 4; ++d0) { sA[0] = MFMA32(kf[d0], qfA[d0], sA[0]); sB[0] = MFMA32(kf[d0], qfB[d0], sB[0]); }
        const bool okA = (kr >= r0A) && (kr < r0A + 8), okB = (kr >= r0B) && (kr < r0B + 8);
        int drA = kr - qiA + 7; drA = drA < 0 ? 0 : (drA > 14 ? 14 : drA); int drB = kr - qiB + 7; drB = drB < 0 ? 0 : (drB > 14 ? 14 : drB);
#pragma unroll
        for (int rr = 0; rr < 16; ++rr) { const int kcol = kb + crow(rr, hi); const bool cv = (kcol >= qs) && (kcol < qs + 16);
            int dc = kcol - qc + 15; dc = dc < 0 ? 0 : (dc > 30 ? 30 : dc);
            sA[0][rr] = (okA && cv) ? sA[0][rr] + rpbL[drA * 31 + dc] : NEGBIG; sB[0][rr] = (okB && cv) ? sB[0][rr] + rpbL[drB * 31 + dc] : NEGBIG; }
        bf16x8 pbA[2], pbB[2];
        softmax_step<1>(sA, mA, lA, oA, pbA, lane);
        softmax_step<1>(sB, mB, lB, oB, pbB, lane);
#pragma unroll
        for (int s2 = 0; s2 < 2; ++s2)
#pragma unroll
            for (int db = 0; db < 2; ++db) { const LAS char* bp = vbase + ((db ^ swz) * 64) + (16 * s2) * 128; const s16x4 lo = vtr(bp), h4 = vtr(bp + 8 * 128);
                const bf16x8 vf = {lo[0], lo[1], lo[2], lo[3], h4[0], h4[1], h4[2], h4[3]};
                oA[db] = MFMA32(vf, pbA[s2], oA[db]); oB[db] = MFMA32(vf, pbB[s2], oB[db]); }
    }
#undef NA_LOAD
#undef NA_ROW
    lA += shx(lA, 32, lane); lB += shx(lB, 32, lane);
    store_o(oA, frcp(lA), MIX + qtokA * 1024 + 512 + h * 64, hi); store_o(oB, frcp(lB), MIX + qtokB * 1024 + 512 + h * 64, hi);
}

constexpr int GM_RS = 1040;
__device__ __forceinline__ void gmlp_unit(int chunk, const bf16* __restrict__ P, const float* __restrict__ vgain, const bf16* __restrict__ wsb, const float* __restrict__ bs, bf16* __restrict__ MIX, LAS char* lds, int wave, int lane) {
    const int r32 = lane & 31, hi = lane >> 5; const size_t tok0 = (size_t)chunk * 128;
    { f32x4 g0 = *(const f32x4*)(vgain + 8 * lane), g1 = *(const f32x4*)(vgain + 8 * lane + 4);
#pragma unroll 4
      for (int j = wave * 16; j < wave * 16 + 16; ++j) {
          const u32x4 raw = *(const u32x4*)(P + (tok0 + j) * OD_IN + 512 + 8 * lane); float f[8];
#pragma unroll
          for (int e = 0; e < 4; ++e) { f[2 * e] = gelu_tanh_(__uint_as_float(raw[e] << 16)); f[2 * e + 1] = gelu_tanh_(__uint_as_float(raw[e] & 0xffff0000u)); }
          float s = 0.f;
#pragma unroll
          for (int e = 0; e < 8; ++e) s += f[e];
          const float mu = wave_sum(s, lane) * (1.f / 512.f); float q = 0.f;
#pragma unroll
          for (int e = 0; e < 8; ++e) { f[e] -= mu; q += f[e] * f[e]; }
          const float rstd = rsqrtf(wave_sum(q, lane) * (1.f / 512.f) + EPS);
          u32x4 w; w.x = pk2(f[0] * rstd * g0.x, f[1] * rstd * g0.y); w.y = pk2(f[2] * rstd * g0.z, f[3] * rstd * g0.w); w.z = pk2(f[4] * rstd * g1.x, f[5] * rstd * g1.y); w.w = pk2(f[6] * rstd * g1.z, f[7] * rstd * g1.w);
          *(LAS u32x4*)(lds + j * GM_RS + lane * 16) = w; } }
    __syncthreads();
    const int g = wave; const int gq = lane >> 4, h2 = gq >> 1;
    const bf16* wg = wsb + (size_t)g * 128 * 128;
#pragma unroll 2
    for (int cb4 = 0; cb4 < 8; ++cb4) {
        const int cbk = cb4 >> 2, ib = cb4 & 3;
        f32x16 acc = f32x16{};
        const LAS char* base = lds + (8 * h2 + ((lane & 15) >> 2)) * GM_RS + (64 * g + 32 * cbk + 16 * (gq & 1) + 4 * (lane & 3)) * 2;
        const bf16* ap = wg + (size_t)(32 * ib + r32) * 128 + 8 * hi;
        const int ch = 64 * g + 32 * cbk + r32;
        unsigned short uraw[16]; float bsv[16];
#pragma unroll
        for (int rr = 0; rr < 16; ++rr) { const int i = 32 * ib + crow(rr, hi); uraw[rr] = P[(tok0 + i) * OD_IN + ch]; bsv[rr] = bs[g * 128 + i]; }
#pragma unroll
        for (int s = 0; s < 8; ++s) {
            const s16x4 lo = vtr(base + (16 * s) * GM_RS), h4 = vtr(base + (16 * s + 4) * GM_RS);
            const bf16x8 vf = {lo[0], lo[1], lo[2], lo[3], h4[0], h4[1], h4[2], h4[3]};
            const bf16x8 af = *(const bf16x8*)(ap + 16 * s);
            acc = MFMA32(af, vf, acc);
        }
#pragma unroll
        for (int rr = 0; rr < 16; ++rr) { const int i = 32 * ib + crow(rr, hi);
            const float uu = gelu_tanh_(bf2f(uraw[rr]));
            MIX[(tok0 + i) * 1024 + ch] = (bf16)(pk2(uu * (acc[rr] + bsv[rr]), 0.f) & 0xffffu); }
    }
    __syncthreads();
}

#ifndef REP_ATT
#define REP_ATT 1
#endif
#ifndef REP_SMALL
#define REP_SMALL 1
#endif
#ifndef REP_G14
#define REP_G14 1
#endif
#ifndef REP_A
#define REP_A 1
#endif
#ifndef REP_ODD
#define REP_ODD 1
#endif
#ifndef REP_M
#define REP_M 1
#endif
#ifndef REP_SYNC
#define REP_SYNC 1
#endif
#ifndef EN_PRO
#define EN_PRO 1
#endif
#ifndef EN_NORM
#define EN_NORM 1
#endif
#ifndef EN_PREP
#define EN_PREP 1
#endif
#ifndef EN_AATT
#define EN_AATT 1
#endif
#ifndef EN_MLA
#define EN_MLA 1
#endif
#ifndef EN_GMLP
#define EN_GMLP 1
#endif
#ifndef EN_NAT
#define EN_NAT 1
#endif
#ifndef EN_G1
#define EN_G1 1
#endif
#ifndef EN_G2
#define EN_G2 1
#endif
#ifndef EN_G3
#define EN_G3 1
#endif
#ifndef EN_G4
#define EN_G4 1
#endif
#ifndef EN_G5
#define EN_G5 1
#endif
__global__ void __launch_bounds__(NTHREADS, 2) fwd_kernel(Args a) {
    extern __shared__ __attribute__((aligned(16))) unsigned char lds_raw[];
    LAS unsigned char* lds = (LAS unsigned char*)lds_raw;
    cg::grid_group grid = cg::this_grid();
    if (threadIdx.x < 4) ((LAS unsigned*)(lds + LDS_MISC))[threadIdx.x] = 0u;
    __syncthreads();
    { XcdBarrier xb0 = xcd_barrier_post((unsigned*)(a.ws + WS_BAR), (volatile LAS unsigned*)(lds + LDS_MISC)); (void)xb0; }
    if (a.ph_lo > 1000) grid.sync();
    const int lo = a.ph_lo, hi_ = a.ph_hi;
#pragma unroll 1
    for (int st = lo; st < hi_; ++st) {
        bool sync_after = (st + 1 < hi_);
        const int tid = otid(), lane = tid & 63, wave = __builtin_amdgcn_readfirstlane(tid >> 6);
        ArgsP ap = (ArgsP)__builtin_amdgcn_kernarg_segment_ptr(); asm volatile("" : "+s"(ap));
    unsigned char* ws = ap->ws;
        bf16* Wb = (bf16*)(ws + WS_W);
        bf16* XN = (bf16*)(ws + WS_XN); bf16* PH = (bf16*)(ws + WS_PH); bf16* MIX = (bf16*)(ws + WS_MIX); bf16* KVb = (bf16*)(ws + WS_KV); bf16* KPE = (bf16*)(ws + WS_KPE);
        float* LSE = (float*)(ws + WS_LSE); float* SSA = (float*)(ws + WS_SSA); float* SSB = (float*)(ws + WS_SSB); const float* ropeC = (const float*)(ws + WS_ROPEC); const float* ropeS = (const float*)(ws + WS_ROPES);
        bf16* CQN = MIX; bf16* CKVN = MIX + (size_t)T * 768;   bf16* OB1 = (bf16*)ap->out; bf16* OB2 = OB1 + (size_t)T * 512;
        float* X = ap->out;
        if (st == 0) { for (int rp = 0; rp < REP_SMALL; ++rp) { if (EN_PRO) prologue(ap, lds, wave, lane); } }
        else if (st == 41) { if (EN_NORM) final_norm_phase(ap->out, XN, ap->in[I_FINAL], SSA, wave, lane); }
        else {
            const int layer = (st - 1) / 10, k = (st - 1) % 10, j = layer >> 1; const bool even = (layer & 1) == 0;
            const float* Xin = layer == 0 ? ap->in[I_X] : X;
            if (k == 0 || k == 2 || k == 7 || (!even && (k == 3 || k == 4))) continue;
            if (k == 0) { for (int rp = 0; rp < REP_SMALL; ++rp) { if (EN_NORM) rmsnorm_phase(Xin, ap->in[I_NMIX] + layer * DM, XN, wave, lane); } }
            else if (k == 7) { for (int rp = 0; rp < REP_SMALL; ++rp) { if (EN_NORM) rmsnorm_phase(X, ap->in[I_NFFN] + layer * DM, XN, wave, lane); } }
            else if (k == 2) { for (int rp = 0; rp < REP_SMALL; ++rp) { if (EN_PREP) mla_prep_phase(PH, CQN, CKVN, KPE, ropeC, ropeS, wave, lane); } }
            else if (k == 5) { for (int rp = 0; rp < REP_ATT; ++rp) {
                if (even) {
                    const int bid_ = obid(), G_ = (int)gridDim.x, n_ = (768 - bid_ + G_ - 1) / G_; const bool flip_ = ((bid_ >> 5) & 1) != 0;
                    for (int i_ = 0; i_ < n_; ++i_) { const int u = bid_ + G_ * (flip_ ? n_ - 1 - i_ : i_);
                        if (u < 256) { const int tid2 = otid(), lane = tid2 & 63, wave = __builtin_amdgcn_readfirstlane(tid2 >> 6); if (EN_AATT) aattn_unit(u >> 4, (u >> 1) & 7, u & 1, PH, ap->in[I_T5], MIX, OB1, OB2, LSE, (LAS char*)lds, wave, lane); }
                        else { const int tid3 = otid(), lane = tid3 & 63, wave = __builtin_amdgcn_readfirstlane(tid3 >> 6); const int v = u - 256; const int bh = (v & 7) + 8 * (v >> 5), qb2 = (v >> 3) & 3; if (EN_MLA) mla_unit2(bh >> 3, bh & 7, qb2, PH, KVb, KPE, ropeC, ropeS, MIX, (LAS char*)lds, wave, lane); }
                    }
                } else {
                    for (int u_ = obid(); u_ < 768; u_ += gridDim.x) { const int u = u_;
                        const int tid2 = otid(), lane = tid2 & 63, wave = __builtin_amdgcn_readfirstlane(tid2 >> 6);
                        if (u < 256) { if (EN_GMLP) gmlp_unit(u, PH, ap->in[I_ODVG] + j * 512, Wb + E_WS + (size_t)j * 8 * 128 * 128, ap->in[I_ODBS] + j * 1024, MIX, (LAS char*)lds, wave, lane); }
                        else { const int task = (u - 256) * 8 + wave; const int cb = task & 3, ipp = (task >> 2) & 7, h = (task >> 5) & 7, b = task >> 8;
                            if (EN_NAT) natten_task2(b, h, ipp, cb, PH, ap->in[I_ODRPB] + (size_t)j * 8 * 465, (LAS float*)(lds + wave * 8192 + 4096), (LAS char*)lds + wave * 8192, MIX, lane); }
                    }
                    __syncthreads();
                }
                if (rp + 1 < REP_ATT) { XcdBarrier xbar; xbar.bar = (unsigned*)(ap->ws + WS_BAR); xbar.x = xb_xcc_id(); xbar.st = (volatile LAS unsigned*)(lds + LDS_MISC); xcd_barrier(xbar); }; }
            } else {
                const bf16* A; const bf16* Bt; int N, K; EpiUni E; E.mode = 0; E.O = PH; E.ldc = EV_INP; E.base = X; E.out = X; E.ss_in = nullptr; E.ss_out = SSA; E.xb = XN; E.wsb = ws; E.qmask = 0xFu; E.sinv = 1.f / DM;
                if (k == 1) { A = XN; K = 1024; E.ss_in = SSA; if (even) { Bt = Wb + E_EVIN + (size_t)j * EV_INP * 1024; N = EV_INP; E.ldc = EV_INP; E.mode = 3; } else { Bt = Wb + E_ODIN + (size_t)j * OD_IN * 1024; N = OD_IN; E.ldc = OD_IN; } }
                else if (k == 3) { A = CQN; Bt = Wb + E_UQ + (size_t)j * 768 * 768; N = 768; K = 768; E.O = PH + 1536; E.ldc = EV_INP; E.ss_in = (const float*)(ws + WS_QSS); E.qmask = 7u; E.sinv = 1.f / 768.f; sync_after = false; }
                else if (k == 4) { A = CKVN; Bt = Wb + E_UKV + (size_t)j * 1024 * 256; N = 1024; K = 256; E.O = KVb; E.ldc = 1024; E.ss_in = (const float*)(ws + WS_QSS); E.qmask = 8u; E.sinv = 1.f / 256.f; }
                else if (k == 6) { A = MIX; Bt = Wb + (even ? E_EVOUT : E_ODOUT) + (size_t)j * 1024 * 1024; N = 1024; K = 1024; E.mode = 2; E.base = Xin; E.ss_out = SSB; }
                else if (k == 8) { A = XN; Bt = Wb + E_GU + (size_t)layer * 2 * FF * 1024; N = 2 * FF; K = 1024; E.mode = 1; E.O = PH; E.ss_in = SSB; }
                else { A = PH; Bt = Wb + E_DN + (size_t)layer * 1024 * FF; N = 1024; K = FF; E.mode = 2; }
                for (int rp = 0; rp < ((k == 1 || k == 8) ? REP_G14 : 1); ++rp) { if (rp) { XcdBarrier xbar; xbar.bar = (unsigned*)(ap->ws + WS_BAR); xbar.x = xb_xcc_id(); xbar.st = (volatile LAS unsigned*)(lds + LDS_MISC); xcd_barrier(xbar); };
                if (EN_G1) { pg8::Gemm g{A, Bt, T, N, K}; pg8::StaticOrder S; S.init(T, N, (int)gridDim.x, (int)obid());
                    pg8::gemm_phase<EpiUni, pg8::StaticOrder, true, true>(lds, g, S, E); } }
            }
        }
        if (sync_after) { for (int rp = 0; rp < REP_SYNC; ++rp) { XcdBarrier xbar; xbar.bar = (unsigned*)(ap->ws + WS_BAR); xbar.x = xb_xcc_id(); xbar.st = (volatile LAS unsigned*)(lds + LDS_MISC); xcd_barrier(xbar); }; }
    }
}

extern "C" void kernel_launch(void* const* d_in, const int* in_sizes, int n_in, void* d_out, int out_size, void* d_ws, size_t ws_size, hipStream_t stream) {
    static int grid = 0;
    if (grid == 0) {
        if (n_in != 19 || out_size != T * DM || ws_size < WS_END) { fprintf(stderr, "kernel_launch: unexpected shapes n_in %d out %d ws %zu (need %zu)\n", n_in, out_size, ws_size, (size_t)WS_END); grid = -1; return; }
        int dev = 0, cus = 0, per_cu = 0;
        (void)hipGetDevice(&dev); (void)hipDeviceGetAttribute(&cus, hipDeviceAttributeMultiprocessorCount, dev);
        if (hipFuncSetAttribute((const void*)fwd_kernel, hipFuncAttributeMaxDynamicSharedMemorySize, LDS_BYTES) != hipSuccess) { fprintf(stderr, "kernel_launch: hipFuncSetAttribute failed\n"); grid = -1; return; }
        if (hipOccupancyMaxActiveBlocksPerMultiprocessor(&per_cu, (const void*)fwd_kernel, NTHREADS, LDS_BYTES) != hipSuccess || per_cu < 1) { fprintf(stderr, "kernel_launch: occupancy query gave %d\n", per_cu); per_cu = 1; }
        (void)hipGetLastError();
        grid = cus * 1;
    }
    if (grid < 0) return;
    if (hipMemsetAsync((char*)d_ws + WS_BAR, 0, BAR_BYTES, stream) != hipSuccess) { fprintf(stderr, "kernel_launch: memset failed\n"); return; }
    Args a{};
    for (int i = 0; i < 19; ++i) a.in[i] = (const float*)d_in[i];
    a.out = (float*)d_out; a.ws = (unsigned char*)d_ws; a.ph_lo = 0; a.ph_hi = 42;
    void* args[] = {&a};
    hipError_t e = hipLaunchCooperativeKernel((const void*)fwd_kernel, dim3(grid), dim3(NTHREADS), args, LDS_BYTES, stream);
    if (e != hipSuccess) fprintf(stderr, "kernel_launch: cooperative launch failed: %s (grid %d)\n", hipGetErrorString(e), grid);
}
```

```cpp
#include <hip/hip_runtime.h>
#include <hip/hip_cooperative_groups.h>
#include <cstdio>
#include <cstdint>
namespace cg = cooperative_groups;
__device__ __forceinline__ int otid() { int t = threadIdx.x; asm volatile("" : "+v"(t)); return t; }
__device__ __forceinline__ int obid() { int t = blockIdx.x; asm volatile("" : "+s"(t)); return t; }
namespace pg8 {
#define PG8_LAS __attribute__((address_space(3)))
typedef unsigned short bf16_t;
typedef short bf16x8 __attribute__((ext_vector_type(8)));
typedef float f32x4 __attribute__((ext_vector_type(4)));
typedef unsigned u32x4 __attribute__((ext_vector_type(4)));
constexpr int BM = 256, BK = 64, HALF = 128, HTB = HALF * BK * 2  , STAGE_BYTES = 8 * HTB, NXCD = 8, WGM = 4;

__host__ __device__ __forceinline__ int lds_byte(int r, int c) { const int st = (r >> 4) * 2 + (c >> 5), rr = r & 15, cc = c & 31, ob = rr * 64 + cc * 2; return st * 1024 + (ob ^ (((ob >> 9) & 1) << 5)); }
__host__ __device__ __forceinline__ void stage_rc(int b, int& R, int& C) { const int st = b / 1024, sb = b % 1024, swz = sb ^ (((sb >> 9) & 1) << 5); R = (st >> 1) * 16 + swz / 64; C = (st & 1) * 32 + (swz % 64) / 2; }
__host__ __device__ __forceinline__ int perm32(int rho) { const int n = rho >> 4, i = rho & 15; return 8 * (i >> 2) + 4 * n + (i & 3); }

struct Unit { int pm, pn; };
struct Gemm { const bf16_t* A; const bf16_t* Bt; int M, N, K; };

struct StaticOrder {
    int nM, nN, nwg, G, c;
    __host__ __device__ void init(int M, int N, int G_, int c_) { nM = M / BM; nN = N / BM; nwg = nM * nN; G = G_; c = c_; }
    __host__ __device__ bool next(int i, Unit& u) const {
        const long L = (long)i * G + c; if (L >= nwg) return false;
        int wgid = (int)L; { const int q = nwg / NXCD, r = nwg % NXCD, xcd = wgid % NXCD, off = wgid / NXCD; wgid = (xcd < r ? xcd * (q + 1) : r * (q + 1) + (xcd - r) * q) + off; }
        const int nig = WGM * nN, gid = wgid / nig, fm = gid * WGM, gsz = (nM - fm) < WGM ? (nM - fm) : WGM;
        u.pm = fm + ((wgid % nig) % gsz); u.pn = (wgid % nig) / gsz; return true;
    }
    __device__ __forceinline__ void a_ready(const Unit&) const {}
    __device__ __forceinline__ void done(const Unit&) const {}
};

__device__ __forceinline__ unsigned cvt_pk_bf16(float lo, float hi) { unsigned r; asm volatile("v_cvt_pk_bf16_f32 %0, %1, %2" : "=v"(r) : "v"(lo), "v"(hi)); return r; }
typedef float f32x2 __attribute__((ext_vector_type(2)));
template <class Epi, class Sched, bool ALIGN_EPI = false, bool SP2 = false>
__device__ __forceinline__ void gemm_phase(PG8_LAS unsigned char* lds, const Gemm g, const Sched& S, const Epi& E_in) {
    Epi E = E_in;
    const int tid = otid(), wid = __builtin_amdgcn_readfirstlane(tid >> 6), lane = tid & 63, wr = wid >> 2, wc = wid & 3, fr = lane & 15, fq = lane >> 4;
    const int K = g.K, nt = K / BK;
    unsigned voffA[2], voffB[2];
#pragma unroll
    for (int i = 0; i < 2; ++i) { int R, C; stage_rc(tid * 16 + i * 8192, R, C); const int Rb = Epi::PERM ? ((R & ~31) + perm32(R & 31)) : R;
        voffA[i] = (unsigned)(R * K + C) * 2u; voffB[i] = (unsigned)(Rb * K + C) * 2u; }
    const size_t kstep = (size_t)(BK * 2);
    const size_t hstep = (size_t)HALF * K * 2;
    const size_t tstep = 2 * hstep;
    const unsigned ldsw = (unsigned)wid * 1024u;
    const int aoff = lds_byte(wr * 64 + fr, fq * 8), boff = lds_byte(wc * 32 + fr, fq * 8);
#define PG8_SA(b, h) (((b) * 2 + (h)) * HTB)
#define PG8_SB(b, h) ((4 + (b) * 2 + (h)) * HTB)
#define PG8_STAGE(bufoff, gbase, voff) do { _Pragma("unroll") for (int _i = 0; _i < 2; ++_i) \
        __builtin_amdgcn_global_load_lds((const unsigned*)((const char*)(gbase) + (voff)[_i]), (PG8_LAS unsigned*)(lds + (bufoff) + ldsw + _i * 8192), 16, 0, 0); } while (0)
#define PG8_LDA(dst, b, h) do { _Pragma("unroll") for (int m = 0; m < 4; ++m) _Pragma("unroll") for (int k = 0; k < 2; ++k) dst[m][k] = *(const PG8_LAS bf16x8*)(lds + PG8_SA(b, h) + aoff + m * 2048 + k * 1024); } while (0)
#define PG8_LDB(dst, b, h) do { _Pragma("unroll") for (int n = 0; n < 2; ++n) _Pragma("unroll") for (int k = 0; k < 2; ++k) dst[n][k] = *(const PG8_LAS bf16x8*)(lds + PG8_SB(b, h) + boff + n * 2048 + k * 1024); } while (0)
#define PG8_MMA(ai, bj, At, Bt) do { __builtin_amdgcn_s_setprio(1); _Pragma("unroll") for (int m = 0; m < 4; ++m) _Pragma("unroll") for (int n = 0; n < 2; ++n) _Pragma("unroll") for (int k = 0; k < 2; ++k) \
        acc[ai][bj][m][n] = __builtin_amdgcn_mfma_f32_16x16x32_bf16(Bt[n][k], At[m][k], acc[ai][bj][m][n], 0, 0, 0); __builtin_amdgcn_s_setprio(0); } while (0)
#define PG8_WAIT_V(n) asm volatile("s_waitcnt vmcnt(" #n ")" ::: "memory")
#define PG8_WAIT_L(n) asm volatile("s_waitcnt lgkmcnt(" #n ")" ::: "memory")
#define PG8_BAR __builtin_amdgcn_s_barrier()
#define PG8_SCHED __builtin_amdgcn_sched_barrier(0)
    Unit cur, nxt; int ui = 0;
    if (!S.next(0, cur)) return;
    f32x4 acc[2][2][4][2];
#pragma unroll
    for (int a = 0; a < 2; ++a)
#pragma unroll
        for (int b = 0; b < 2; ++b)
#pragma unroll
            for (int m = 0; m < 4; ++m)
#pragma unroll
                for (int n = 0; n < 2; ++n) acc[a][b][m][n] = (f32x4){0.f, 0.f, 0.f, 0.f};
    bf16x8 At[4][2], B0[2][2], B1[2][2];
    const char* cA = (const char*)g.A + (size_t)cur.pm * tstep; const char* cB = (const char*)g.Bt + (size_t)cur.pn * tstep;
    S.a_ready(cur); E.pre(cur, wr, fr, fq);
    if constexpr (SP2) {
        PG8_STAGE(PG8_SB(0, 0), cB, voffB); PG8_STAGE(PG8_SB(0, 1), cB + hstep, voffB); PG8_STAGE(PG8_SA(0, 0), cA, voffA); PG8_STAGE(PG8_SA(0, 1), cA + hstep, voffA);
        if (wr == 1) PG8_BAR;
        PG8_WAIT_V(2); PG8_BAR;
        PG8_STAGE(PG8_SB(1, 0), cB + kstep, voffB); PG8_STAGE(PG8_SA(1, 0), cA + kstep, voffA); PG8_STAGE(PG8_SB(1, 1), cB + hstep + kstep, voffB);
        PG8_WAIT_V(6); PG8_BAR;
    } else {
        PG8_STAGE(PG8_SB(0, 0), cB, voffB); PG8_STAGE(PG8_SA(0, 0), cA, voffA); PG8_STAGE(PG8_SB(0, 1), cB + hstep, voffB); PG8_STAGE(PG8_SA(0, 1), cA + hstep, voffA);
        if (wr == 1) PG8_BAR;
        PG8_WAIT_V(4); PG8_BAR;
        PG8_STAGE(PG8_SB(1, 0), cB + kstep, voffB); PG8_STAGE(PG8_SA(1, 0), cA + kstep, voffA); PG8_STAGE(PG8_SB(1, 1), cB + hstep + kstep, voffB);
        PG8_WAIT_V(6); PG8_BAR;
    }
    for (;;) {
        const bool has_next = S.next(ui + 1, nxt);
        const char* nA = has_next ? (const char*)g.A + (size_t)nxt.pm * tstep : cA; const char* nB = has_next ? (const char*)g.Bt + (size_t)nxt.pn * tstep : cB;
        for (int t = 0; t < nt; t += 2) {
            const bool last = (t == nt - 2);
            const char* a1 = cA + (size_t)(t + 1) * kstep;
            const char* a2 = last ? nA : cA + (size_t)(t + 2) * kstep; const char* b2 = last ? nB : cB + (size_t)(t + 2) * kstep;
            const char* a3 = a2 + kstep; const char* b3 = b2 + kstep;
            if (last && has_next) S.a_ready(nxt);
            if constexpr (SP2) {
            PG8_LDB(B0, 0, 0); PG8_LDB(B1, 0, 1); PG8_SCHED; PG8_LDA(At, 0, 0); PG8_STAGE(PG8_SA(1, 1), a1 + hstep, voffA);
            PG8_WAIT_V(8); PG8_WAIT_L(0); PG8_BAR; PG8_MMA(0, 0, At, B0); PG8_MMA(0, 1, At, B1); PG8_BAR; PG8_SCHED;
            PG8_LDA(At, 0, 1); PG8_STAGE(PG8_SB(0, 0), b2, voffB); PG8_STAGE(PG8_SB(0, 1), b2 + hstep, voffB); PG8_STAGE(PG8_SA(0, 0), a2, voffA);
            PG8_WAIT_V(8); PG8_WAIT_L(0); PG8_BAR; PG8_MMA(1, 0, At, B0); PG8_MMA(1, 1, At, B1); PG8_BAR; PG8_SCHED;
            PG8_LDB(B0, 1, 0); PG8_LDB(B1, 1, 1); PG8_SCHED; PG8_LDA(At, 1, 0); PG8_STAGE(PG8_SA(0, 1), a2 + hstep, voffA);
            PG8_WAIT_V(8); PG8_WAIT_L(0); PG8_BAR; PG8_MMA(0, 0, At, B0); PG8_MMA(0, 1, At, B1); PG8_BAR; PG8_SCHED;
            PG8_LDA(At, 1, 1); PG8_STAGE(PG8_SB(1, 0), b3, voffB); PG8_STAGE(PG8_SB(1, 1), b3 + hstep, voffB); PG8_STAGE(PG8_SA(1, 0), a3, voffA);
            PG8_WAIT_V(8); PG8_WAIT_L(0); PG8_BAR; PG8_MMA(1, 0, At, B0); PG8_MMA(1, 1, At, B1); PG8_BAR; PG8_SCHED;
            } else {
            PG8_LDB(B0, 0, 0); PG8_SCHED; PG8_LDA(At, 0, 0); PG8_STAGE(PG8_SA(1, 1), a1 + hstep, voffA);
            PG8_WAIT_L(8); PG8_BAR; PG8_WAIT_L(0); PG8_MMA(0, 0, At, B0); PG8_BAR; PG8_SCHED;
            PG8_LDB(B1, 0, 1); PG8_STAGE(PG8_SB(0, 0), b2, voffB);
            PG8_BAR; PG8_WAIT_L(0); PG8_MMA(0, 1, At, B1); PG8_BAR;
            PG8_LDA(At, 0, 1); PG8_STAGE(PG8_SA(0, 0), a2, voffA);
            PG8_BAR; PG8_WAIT_L(0); PG8_MMA(1, 0, At, B0); PG8_BAR; PG8_SCHED;
            PG8_STAGE(PG8_SB(0, 1), b2 + hstep, voffB);
            PG8_WAIT_V(6); PG8_BAR; PG8_MMA(1, 1, At, B1); PG8_BAR;
            PG8_LDB(B0, 1, 0); PG8_SCHED; PG8_LDA(At, 1, 0); PG8_STAGE(PG8_SA(0, 1), a2 + hstep, voffA);
            PG8_WAIT_L(8); PG8_BAR; PG8_WAIT_L(0); PG8_MMA(0, 0, At, B0); PG8_BAR; PG8_SCHED;
            PG8_LDB(B1, 1, 1); PG8_STAGE(PG8_SB(1, 0), b3, voffB);
            PG8_BAR; PG8_WAIT_L(0); PG8_MMA(0, 1, At, B1); PG8_BAR;
            PG8_LDA(At, 1, 1); PG8_STAGE(PG8_SA(1, 0), a3, voffA);
            PG8_BAR; PG8_WAIT_L(0); PG8_MMA(1, 0, At, B0); PG8_BAR; PG8_SCHED;
            PG8_STAGE(PG8_SB(1, 1), b3 + hstep, voffB);
            PG8_WAIT_V(6); PG8_BAR; PG8_MMA(1, 1, At, B1); PG8_BAR;
            }
        }
        if constexpr (ALIGN_EPI) { if (wr == 0) PG8_BAR; }
        if constexpr (!Epi::AFTER_DRAIN) { E(acc, cur, wr, wc, fr, fq); S.done(cur); if (has_next) E.pre(nxt, wr, fr, fq); }
        if (!has_next) break;
#pragma unroll
        for (int a = 0; a < 2; ++a)
#pragma unroll
            for (int b = 0; b < 2; ++b)
#pragma unroll
                for (int m = 0; m < 4; ++m)
#pragma unroll
                    for (int n = 0; n < 2; ++n) acc[a][b][m][n] = (f32x4){0.f, 0.f, 0.f, 0.f};
        cur = nxt; cA = nA; cB = nB; ++ui;
        if constexpr (ALIGN_EPI) { if (wr == 1) PG8_BAR; }
    }
    PG8_WAIT_V(0);
    if constexpr (!ALIGN_EPI) { if (wr == 0) PG8_BAR; }
    PG8_BAR;
    if constexpr (Epi::AFTER_DRAIN) { E.fused(acc, cur, wr, wc, fr, fq, lds, wid, lane); S.done(cur); }
#undef PG8_SA
#undef PG8_SB
#undef PG8_STAGE
#undef PG8_LDA
#undef PG8_LDB
#undef PG8_MMA
#undef PG8_WAIT_V
#undef PG8_WAIT_L
#undef PG8_BAR
#undef PG8_SCHED
}
}

#define LAS __attribute__((address_space(3)))
typedef unsigned short bf16;
typedef short bf16x8 __attribute__((ext_vector_type(8)));
typedef short s16x4 __attribute__((ext_vector_type(4)));
typedef short v4i16_t __attribute__((ext_vector_type(4)));
typedef float f32x4 __attribute__((ext_vector_type(4)));
typedef float f32x2 __attribute__((ext_vector_type(2)));
typedef float f32x16 __attribute__((ext_vector_type(16)));
typedef unsigned u32x4 __attribute__((ext_vector_type(4)));
typedef unsigned u32x2 __attribute__((ext_vector_type(2)));
typedef __bf16 bf16x2_t __attribute__((ext_vector_type(2)));

constexpr int T = 32768, SEQ = 2048, NBATCH = 16, DM = 1024;
constexpr int EV_IN = 2592, EV_INP = 2816, OD_IN = 2560, FF = 2816;
constexpr float LOG2E = 1.4426950408889634f;
constexpr float EPS = 1e-6f;
constexpr float NEGBIG = -1e30f;

constexpr size_t MiB = 1u << 20;
constexpr size_t WS_ROPEC = 0, WS_ROPES = 128 * 1024;
constexpr size_t WS_SSA = 474 * MiB, WS_SSB = 476 * MiB;
constexpr size_t WS_BAR = 512 * 1024, BAR_BYTES = 16384;
constexpr size_t WS_W = 1 * MiB;
constexpr size_t E_EVIN = 0;
constexpr size_t E_UQ = E_EVIN + 2ull * EV_INP * 1024;
constexpr size_t E_UKV = E_UQ + 2ull * 768 * 768;
constexpr size_t E_EVOUT = E_UKV + 2ull * 1024 * 256;
constexpr size_t E_ODIN = E_EVOUT + 2ull * 1024 * 1024;
constexpr size_t E_ODOUT = E_ODIN + 2ull * OD_IN * 1024;
constexpr size_t E_GU = E_ODOUT + 2ull * 1024 * 1024;
constexpr size_t E_DN = E_GU + 4ull * 2 * FF * 1024;
constexpr size_t E_WS = E_DN + 4ull * 1024 * FF;
constexpr size_t E_END = E_WS + 2ull * 8 * 128 * 128;
static_assert(E_END * 2 <= 100 * MiB, "weights fit");
constexpr size_t WS_XN = 101 * MiB;
constexpr size_t WS_PH = 165 * MiB;
constexpr size_t WS_MIX = 341 * MiB;
constexpr size_t WS_KV = 405 * MiB;
constexpr size_t WS_KPE = 469 * MiB;
constexpr size_t WS_LSE = 471 * MiB;
constexpr size_t WS_QSS = 478 * MiB;
constexpr size_t WS_END = 480 * MiB;

constexpr int NWAVES = 8, NTHREADS = 512;
constexpr int LDS_BYTES = 147456, LDS_MISC = 140288;

#define RLX_AGENT __ATOMIC_RELAXED, __HIP_MEMORY_SCOPE_AGENT
#define XB_TMO      128
#define XB_XCNT(j)  (256  + 64 * (j))
#define XB_XSUB(j)  (1280 + 64 * (j))
#define XB_XGEN(j)  (2304 + 64 * (j))
#define XB_TOP      3328
#define XB_TOPGEN   3392
#define XCD_BAR_WORDS 3456
#define XB_SPIN_CAP (1u << 18)

__device__ __forceinline__ unsigned xb_ld(unsigned* p)              { return __hip_atomic_load(p, __ATOMIC_RELAXED, __HIP_MEMORY_SCOPE_AGENT); }
__device__ __forceinline__ unsigned xb_add(unsigned* p, unsigned v) { return __hip_atomic_fetch_add(p, v, __ATOMIC_RELAXED, __HIP_MEMORY_SCOPE_AGENT); }
__device__ __forceinline__ unsigned xb_xcc_id() { return (unsigned)__builtin_amdgcn_s_getreg((3 << 11) | 20) & 0xFu; }
#define XB_SPIN(cond, bar) do { unsigned _sp = 0; while (cond) { __builtin_amdgcn_s_sleep(1); \
    if ((++_sp & 255u) == 0u) { if (xb_ld(&(bar)[XB_TMO])) break; if (_sp > XB_SPIN_CAP) { atomicAdd(&(bar)[XB_TMO], 1u); break; } } } } while (0)

struct XcdBarrier {
    unsigned* bar; unsigned x;
    volatile LAS unsigned* st;
};

__device__ __forceinline__ XcdBarrier xcd_barrier_post(unsigned* bar, volatile LAS unsigned* st) {
    XcdBarrier b; b.bar = bar; b.x = xb_xcc_id(); b.st = st;
    if (threadIdx.x == 0) (void)xb_add(&bar[XB_XCNT(b.x)], 1u);
    return b;
}
__device__ __forceinline__ void xcd_barrier_complete(unsigned* bar, unsigned x, unsigned& nloc, unsigned& nx) {
    const unsigned G = gridDim.x * gridDim.y * gridDim.z;
    unsigned sum, cnt, mine, sp = 0u;
    for (;;) {
        sum = 0u; cnt = 0u; mine = 0u;
#pragma unroll
        for (unsigned j = 0; j < 16; ++j) { const unsigned c = xb_ld(&bar[XB_XCNT(j)]); sum += c; cnt += (c > 0u) ? 1u : 0u; mine = (j == x) ? c : mine; }
        if (sum == G) break;
        __builtin_amdgcn_s_sleep(1);
        if ((++sp & 255u) == 0u) { if (xb_ld(&bar[XB_TMO])) break; if (sp > XB_SPIN_CAP) { atomicAdd(&bar[XB_TMO], 1u); break; } }
    }
    nloc = mine > 0u ? mine : 1u; nx = cnt > 0u ? cnt : 1u;
}

__device__ __forceinline__ void xcd_barrier(const XcdBarrier& b) {
    asm volatile("s_waitcnt vmcnt(0)" ::: "memory");
    __syncthreads();
    if (threadIdx.x == 0) {
        unsigned* bar = b.bar;
        __builtin_amdgcn_s_waitcnt(0);
        unsigned nloc = b.st[0], nx = b.st[1];
        if (nloc == 0u) { xcd_barrier_complete(bar, b.x, nloc, nx); b.st[0] = nloc; b.st[1] = nx; }
        const unsigned old = xb_add(&bar[XB_XSUB(b.x)], 1u);
        const unsigned gen = old / nloc;
        if (old + 1u == (gen + 1u) * nloc) {
            __builtin_amdgcn_fence(__ATOMIC_RELEASE, "agent");
            asm volatile("s_waitcnt vmcnt(0)" ::: "memory");
            const unsigned og = xb_add(&bar[XB_TOP], 1u);
            const unsigned tg = og / nx;
            if (og + 1u == (tg + 1u) * nx) xb_add(&bar[XB_TOPGEN], 1u);
            else XB_SPIN(xb_ld(&bar[XB_TOPGEN]) == tg, bar);
            __builtin_amdgcn_fence(__ATOMIC_ACQUIRE, "agent");
            xb_add(&bar[XB_XGEN(b.x)], 1u);
            asm volatile("s_waitcnt vmcnt(0)" ::: "memory");
        } else {
            XB_SPIN(xb_ld(&bar[XB_XGEN(b.x)]) == gen, bar);
            __builtin_amdgcn_fence(__ATOMIC_ACQUIRE, "agent");
            asm volatile("s_waitcnt vmcnt(0)" ::: "memory");
        }
    }
    __syncthreads();
}

__device__ __forceinline__ float bf2f(unsigned short b) { return __uint_as_float((unsigned)b << 16); }
__device__ __forceinline__ unsigned pk2(float lo, float hi) { f32x2 v = {lo, hi}; bf16x2_t b = __builtin_convertvector(v, bf16x2_t); return __builtin_bit_cast(unsigned, b); }
__device__ __forceinline__ float shx(float v, int mask, int lane) { return __int_as_float(__builtin_amdgcn_ds_bpermute((lane ^ mask) << 2, __float_as_int(v))); }
__device__ __forceinline__ float shi(float v, int src) { return __int_as_float(__builtin_amdgcn_ds_bpermute(src << 2, __float_as_int(v))); }
__device__ __forceinline__ float wave_sum(float v, int lane) {
#pragma unroll
    for (int o = 1; o < 64; o <<= 1) v += shx(v, o, lane);
    return v;
}
__device__ __forceinline__ float fexp2(float x) { return __builtin_amdgcn_exp2f(x); }
__device__ __forceinline__ float frcp(float x) { return __builtin_amdgcn_rcpf(x); }
__device__ __forceinline__ float sigmoidf_(float z) { return frcp(1.0f + fexp2(-z * LOG2E)); }
__device__ __forceinline__ float silu_(float x) { return x * sigmoidf_(x); }
__device__ __forceinline__ float gelu_tanh_(float x) { return x * sigmoidf_(1.5957691216057308f * (x + 0.044715f * x * x * x)); }
__device__ __forceinline__ float row_rstd(const float* ss, int row) { const f32x4* p = (const f32x4*)(ss + (size_t)row * 16); const f32x4 a = p[0], b = p[1], c = p[2], d = p[3];
    const f32x4 t = (a + b) + (c + d); return rsqrtf(((t[0] + t[1]) + (t[2] + t[3])) * (1.f / DM) + EPS); }
__device__ __forceinline__ float row_rstd_m(const float* ss, int row, unsigned qmask, float sinv) { const f32x4* p = (const f32x4*)(ss + (size_t)row * 16); const f32x4 a = p[0], b = p[1], c = p[2], d = p[3];
    f32x4 t = {0.f, 0.f, 0.f, 0.f}; if (qmask & 1u) t += a; if (qmask & 2u) t += b; if (qmask & 4u) t += c; if (qmask & 8u) t += d; return rsqrtf(((t[0] + t[1]) + (t[2] + t[3])) * sinv + EPS); }
__device__ __forceinline__ int crow(int r, int hi) { return (r & 3) + 8 * (r >> 2) + 4 * hi; }
__device__ __forceinline__ s16x4 vtr(const LAS char* p) { return __builtin_bit_cast(s16x4, __builtin_amdgcn_ds_read_tr16_b64_v4i16((LAS v4i16_t*)p)); }
#define MFMA32(a, b, c) __builtin_amdgcn_mfma_f32_32x32x16_bf16((a), (b), (c), 0, 0, 0)
__device__ __forceinline__ bf16x8 pack8(const f32x16& x, int s) {
    u32x4 p; p.x = pk2(x[8 * s], x[8 * s + 1]); p.y = pk2(x[8 * s + 2], x[8 * s + 3]); p.z = pk2(x[8 * s + 4], x[8 * s + 5]); p.w = pk2(x[8 * s + 6], x[8 * s + 7]);
    return __builtin_bit_cast(bf16x8, p);
}

struct EpiUni {
    static constexpr bool PERM = true, AFTER_DRAIN = false;
    int mode; bf16* O; int ldc; const float* base; float* out; const float* ss_in; float* ss_out; bf16* xb;
    unsigned char* wsb; unsigned qmask; float sinv;
    float rs0, rs1;
    __device__ __forceinline__ void pre(const pg8::Unit& u, int wr, int fr, int fq) { rs0 = 1.f; rs1 = 1.f;
        if (ss_in) { const int r = u.pm * 256 + wr * 64 + fr + 16 * fq; rs0 = row_rstd_m(ss_in, r, qmask, sinv); rs1 = row_rstd_m(ss_in, r + 128, qmask, sinv); } }
    __device__ __forceinline__ void operator()(const pg8::f32x4 (&acc)[2][2][4][2], const pg8::Unit& u, int wr, int wc, int fr, int fq) const {
        const int row0 = u.pm * 256 + wr * 64 + fr;
        if (mode == 0 || mode == 3) {
            bf16* Ob = O; int ld = ldc; int col0 = u.pn * 256 + wc * 32 + 8 * fq; float* qs = nullptr; bool rope = false;
            unsigned char* wsl = wsb; asm volatile("" : "+s"(wsl));
            if (mode == 3 && u.pn >= 6) {
                if (u.pn < 9) { Ob = (bf16*)(wsl + WS_MIX); ld = 768; col0 -= 1536; qs = (float*)(wsl + WS_QSS) + (u.pn - 6) * 4 + wc; }
                else if (u.pn == 9) { Ob = (bf16*)(wsl + WS_MIX) + (size_t)T * 768; ld = 256; col0 -= 2304; qs = (float*)(wsl + WS_QSS) + 12 + wc; }
                else rope = true;
            }
            if (!rope) {
#pragma unroll
                for (int ai = 0; ai < 2; ++ai)
#pragma unroll
                    for (int m = 0; m < 4; ++m) { const int row = row0 + ai * 128 + m * 16; bf16* rowp = Ob + (size_t)row * ld + col0;
                        const float rs = shi(ai == 0 ? rs0 : rs1, fr + 16 * m); float q = 0.f;
#pragma unroll
                        for (int bj = 0; bj < 2; ++bj) { const pg8::f32x4 v0 = acc[ai][bj][m][0] * rs, v1 = acc[ai][bj][m][1] * rs;
                            u32x4 w; w.x = pk2(v0[0], v0[1]); w.y = pk2(v0[2], v0[3]); w.z = pk2(v1[0], v1[1]); w.w = pk2(v1[2], v1[3]);
                            *(u32x4*)(rowp + bj * 128) = w;
                            q += (v0[0] * v0[0] + v0[1] * v0[1]) + (v0[2] * v0[2] + v0[3] * v0[3]) + (v1[0] * v1[0] + v1[1] * v1[1]) + (v1[2] * v1[2] + v1[3] * v1[3]); }
                        if (qs) { q += shx(q, 16, fr + 16 * fq); q += shx(q, 32, fr + 16 * fq); if (fq == 0) qs[(size_t)row * 16] = q; } }
            } else if (wc == 0) {
                const float* rc = (const float*)(wsl + WS_ROPEC); const float* rsn = (const float*)(wsl + WS_ROPES); bf16* kpe = (bf16*)(wsl + WS_KPE);
                const int ln = fr + 16 * fq, i0 = 8 * (fq & 1);
#pragma unroll
                for (int ai = 0; ai < 2; ++ai)
#pragma unroll
                    for (int m = 0; m < 4; ++m) { const int row = row0 + ai * 128 + m * 16, pos = row & (SEQ - 1);
                        const float rs = shi(ai == 0 ? rs0 : rs1, fr + 16 * m);
                        const pg8::f32x4 v0 = acc[ai][0][m][0] * rs, v1 = acc[ai][0][m][1] * rs; pg8::f32x4 p0, p1;
#pragma unroll
                        for (int e = 0; e < 4; ++e) { p0[e] = shx(v0[e], 32, ln); p1[e] = shx(v1[e], 32, ln); }
                        const f32x4 c0 = *(const f32x4*)(rc + pos * 16 + i0), c1 = *(const f32x4*)(rc + pos * 16 + i0 + 4), s0 = *(const f32x4*)(rsn + pos * 16 + i0), s1 = *(const f32x4*)(rsn + pos * 16 + i0 + 4);
                        f32x4 o0, o1;
                        if (fq < 2) { o0 = v0 * c0 - p0 * s0; o1 = v1 * c1 - p1 * s1; } else { o0 = p0 * s0 + v0 * c0; o1 = p1 * s1 + v1 * c1; }
                        u32x4 w; w.x = pk2(o0[0], o0[1]); w.y = pk2(o0[2], o0[3]); w.z = pk2(o1[0], o1[1]); w.w = pk2(o1[2], o1[3]);
                        *(u32x4*)(kpe + (size_t)row * 32 + 8 * fq) = w; }
            }
        } else if (mode == 1) {
            const int col0 = u.pn * 128 + wc * 32 + 8 * fq;
#pragma unroll
            for (int ai = 0; ai < 2; ++ai)
#pragma unroll
                for (int m = 0; m < 4; ++m) { bf16* rowp = O + (size_t)(row0 + ai * 128 + m * 16) * FF + col0;
                    const float rs = shi(ai == 0 ? rs0 : rs1, fr + 16 * m);
                    const pg8::f32x4 g0 = acc[ai][0][m][0] * rs, g1 = acc[ai][0][m][1] * rs, u0 = acc[ai][1][m][0] * rs, u1 = acc[ai][1][m][1] * rs;
                    u32x4 w; w.x = pk2(silu_(g0[0]) * u0[0], silu_(g0[1]) * u0[1]); w.y = pk2(silu_(g0[2]) * u0[2], silu_(g0[3]) * u0[3]);
                    w.z = pk2(silu_(g1[0]) * u1[0], silu_(g1[1]) * u1[1]); w.w = pk2(silu_(g1[2]) * u1[2], silu_(g1[3]) * u1[3]);
                    *(u32x4*)rowp = w; }
        } else {
            const int col0 = u.pn * 256 + wc * 32 + 8 * fq;
            u32x4 bb[2][4][2];
#pragma unroll
            for (int ai = 0; ai < 2; ++ai)
#pragma unroll
                for (int m = 0; m < (ai == 0 ? 4 : 2); ++m) { const size_t off = (size_t)(row0 + ai * 128 + m * 16) * DM + col0;
#pragma unroll
                    for (int bj = 0; bj < 2; ++bj) bb[ai][m][bj] = *(const u32x4*)(xb + off + bj * 128); }
            asm volatile("" ::: "memory");
#pragma unroll
            for (int ai = 0; ai < 2; ++ai) {
#pragma unroll
                for (int m = 0; m < 4; ++m) { const size_t off = (size_t)(row0 + ai * 128 + m * 16) * DM + col0; float q = 0.f;
#pragma unroll
                    for (int bj = 0; bj < 2; ++bj) { const u32x4 b = bb[ai][m][bj];
                        const f32x4 b0 = {__uint_as_float(b.x << 16), __uint_as_float(b.x & 0xffff0000u), __uint_as_float(b.y << 16), __uint_as_float(b.y & 0xffff0000u)};
                        const f32x4 b1 = {__uint_as_float(b.z << 16), __uint_as_float(b.z & 0xffff0000u), __uint_as_float(b.w << 16), __uint_as_float(b.w & 0xffff0000u)};
                        const f32x4 x0 = b0 + acc[ai][bj][m][0], x1 = b1 + acc[ai][bj][m][1];
                        u32x4 w; w.x = pk2(x0[0], x0[1]); w.y = pk2(x0[2], x0[3]); w.z = pk2(x1[0], x1[1]); w.w = pk2(x1[2], x1[3]);
                        *(u32x4*)(xb + off + bj * 128) = w;
                        q += (x0[0] * x0[0] + x0[1] * x0[1]) + (x0[2] * x0[2] + x0[3] * x0[3]) + (x1[0] * x1[0] + x1[1] * x1[1]) + (x1[2] * x1[2] + x1[3] * x1[3]); }
                    q += shx(q, 16, fr + 16 * fq); q += shx(q, 32, fr + 16 * fq);
                    if (fq == 0) ss_out[(size_t)(row0 + ai * 128 + m * 16) * 16 + u.pn * 4 + wc] = q; }
                if (ai == 0) { asm volatile("" ::: "memory");
#pragma unroll
                    for (int m = 2; m < 4; ++m) { const size_t off = (size_t)(row0 + 128 + m * 16) * DM + col0;
#pragma unroll
                        for (int bj = 0; bj < 2; ++bj) bb[1][m][bj] = *(const u32x4*)(xb + off + bj * 128); }
                    asm volatile("" ::: "memory"); }
            }
            asm volatile("" ::: "memory");
        }
    }
};

struct ConvDesc { const float* W; int K, N; bf16* WT; int mode; const float* kscale; int cs_lo, cs_hi; float cs_val; };
__device__ __forceinline__ int maprow(int mode, int n) { if (mode == 1) { const int half = n >= FF ? 1 : 0, nn = n - half * FF; return 256 * (nn >> 7) + 128 * half + (nn & 127); } return n; }
__device__ __forceinline__ void conv_matrix(const ConvDesc& d, LAS float* scr, int gw, int ngw, int lane) {
    const int nblk = d.N / 32, nitems = (d.K / 64) * nblk;
    for (int item = gw; item < nitems; item += ngw) {
        const int kb = item / nblk, nb = item % nblk, k0 = 64 * kb, n0 = 32 * nb;
        const float cs = (n0 >= d.cs_lo && n0 < d.cs_hi) ? d.cs_val : 1.0f;
        scr[64 * 33 + lane] = d.kscale ? d.kscale[k0 + lane] : 1.0f;
#pragma unroll 8
        for (int i = 0; i < 32; ++i) { const int kk = 2 * i + (lane >> 5); scr[kk * 33 + (lane & 31)] = d.W[(size_t)(k0 + kk) * d.N + n0 + (lane & 31)] * (cs * scr[64 * 33 + kk]); }
        const int c = lane & 7;
#pragma unroll
        for (int j = 0; j < 4; ++j) { const int n = (lane >> 3) + 8 * j; const LAS float* s = scr + (8 * c) * 33 + n;
            u32x4 o; o.x = pk2(s[0 * 33], s[1 * 33]); o.y = pk2(s[2 * 33], s[3 * 33]); o.z = pk2(s[4 * 33], s[5 * 33]); o.w = pk2(s[6 * 33], s[7 * 33]);
            *(u32x4*)(d.WT + (size_t)maprow(d.mode, n0 + n) * d.K + k0 + 8 * c) = o; }
    }
}

struct Args { const float* in[19]; float* out; unsigned char* ws; int ph_lo, ph_hi; };
enum { I_X = 0, I_T5, I_NMIX, I_NFFN, I_EVWIN, I_EVQG, I_EVKVG, I_EVWUQ, I_EVWUKV, I_EVWOUT, I_ODWIN, I_ODVG, I_ODWS, I_ODBS, I_ODRPB, I_ODWOUT, I_FFNGU, I_FFNDN, I_FINAL };

typedef const __attribute__((address_space(4))) Args* ArgsP;
__device__ __forceinline__ void prologue(ArgsP ap, LAS unsigned char* lds, int wave, int lane) {
    bf16* Wb = (bf16*)(ap->ws + WS_W);
    LAS float* scr = (LAS float*)(lds + wave * 16384);
    const int gw = obid() * NWAVES + wave, ngw = gridDim.x * NWAVES;
    const float SA = 0.125f * LOG2E, SB = 0.10206207261596575f * LOG2E;
    for (int j = 0; j < 2; ++j) {
        { ConvDesc d{ap->in[I_EVWIN] + (size_t)j * 1024 * EV_IN, 1024, EV_IN, Wb + E_EVIN + (size_t)j * EV_INP * 1024, 0, ap->in[I_NMIX] + (2 * j) * DM, 0, 512, SA}; conv_matrix(d, scr, gw, ngw, lane); }
        { ConvDesc d{ap->in[I_EVWUQ] + (size_t)j * 768 * 768, 768, 768, Wb + E_UQ + (size_t)j * 768 * 768, 0, ap->in[I_EVQG] + j * 768, 0, 768, SB}; conv_matrix(d, scr, gw, ngw, lane); }
        { ConvDesc d{ap->in[I_EVWUKV] + (size_t)j * 256 * 1024, 256, 1024, Wb + E_UKV + (size_t)j * 1024 * 256, 0, ap->in[I_EVKVG] + j * 256, 0, 0, 1.f}; conv_matrix(d, scr, gw, ngw, lane); }
        { ConvDesc d{ap->in[I_EVWOUT] + (size_t)j * 1024 * 1024, 1024, 1024, Wb + E_EVOUT + (size_t)j * 1024 * 1024, 0, nullptr, 0, 0, 1.f}; conv_matrix(d, scr, gw, ngw, lane); }
        { ConvDesc d{ap->in[I_ODWIN] + (size_t)j * 1024 * OD_IN, 1024, OD_IN, Wb + E_ODIN + (size_t)j * OD_IN * 1024, 0, ap->in[I_NMIX] + (2 * j + 1) * DM, 1024, 1536, SA}; conv_matrix(d, scr, gw, ngw, lane); }
        { ConvDesc d{ap->in[I_ODWOUT] + (size_t)j * 1024 * 1024, 1024, 1024, Wb + E_ODOUT + (size_t)j * 1024 * 1024, 0, nullptr, 0, 0, 1.f}; conv_matrix(d, scr, gw, ngw, lane); }
    }
    for (int l = 0; l < 4; ++l) {
        { ConvDesc d{ap->in[I_FFNGU] + (size_t)l * 1024 * 2 * FF, 1024, 2 * FF, Wb + E_GU + (size_t)l * 2 * FF * 1024, 1, ap->in[I_NFFN] + l * DM, 0, 0, 1.f}; conv_matrix(d, scr, gw, ngw, lane); }
        { ConvDesc d{ap->in[I_FFNDN] + (size_t)l * FF * 1024, FF, 1024, Wb + E_DN + (size_t)l * 1024 * FF, 0, nullptr, 0, 0, 1.f}; conv_matrix(d, scr, gw, ngw, lane); }
    }
    { bf16* XB = (bf16*)(ap->ws + WS_XN); float* SSA = (float*)(ap->ws + WS_SSA); const float* X0 = ap->in[I_X];
#pragma unroll 4
      for (int row = gw; row < T; row += ngw) {
          const f32x4* xr = (const f32x4*)(X0 + (size_t)row * DM) + lane; f32x4 v[4]; float sq = 0.f;
#pragma unroll
          for (int jj = 0; jj < 4; ++jj) { v[jj] = xr[64 * jj]; sq += (v[jj].x * v[jj].x + v[jj].y * v[jj].y) + (v[jj].z * v[jj].z + v[jj].w * v[jj].w); }
          sq = wave_sum(sq, lane); if (lane < 16) SSA[(size_t)row * 16 + lane] = lane == 0 ? sq : 0.f;
          u32x2* o = (u32x2*)(XB + (size_t)row * DM) + lane;
#pragma unroll
          for (int jj = 0; jj < 4; ++jj) { u32x2 w; w.x = pk2(v[jj].x, v[jj].y); w.y = pk2(v[jj].z, v[jj].w); o[64 * jj] = w; } } }
    const int gt = obid() * NTHREADS + otid(), ngt = gridDim.x * NTHREADS;
    for (int j = 0; j < 2; ++j) { u32x4* z = (u32x4*)(Wb + E_EVIN + (size_t)j * EV_INP * 1024 + (size_t)EV_IN * 1024); unsigned z0 = 0u; asm volatile("" : "+v"(z0)); for (int i = gt; i < (EV_INP - EV_IN) * 1024 / 8; i += ngt) z[i] = (u32x4){z0, z0, z0, z0}; }
    { const float* ws = ap->in[I_ODWS]; unsigned* o = (unsigned*)(Wb + E_WS); for (int i = gt; i < 2 * 8 * 128 * 128 / 2; i += ngt) o[i] = pk2(ws[2 * i], ws[2 * i + 1]); }
    { float* rc = (float*)(ap->ws + WS_ROPEC); float* rs = (float*)(ap->ws + WS_ROPES);
      for (int i = gt; i < 2048 * 16; i += ngt) { const int pos = i >> 4, k = i & 15; const float inv = 1.0f / powf(10000.0f, (float)(2 * k) / 32.0f); const float ang = (float)pos * inv;
          double rev = (double)ang * 0.15915494309189535; rev -= rint(rev); const float fr = (float)rev; rc[i] = __builtin_amdgcn_cosf(fr); rs[i] = __builtin_amdgcn_sinf(fr); } }
}

__device__ __forceinline__ void rmsnorm_phase(const float* X, const float* g, bf16* XN, int wave, int lane) {
    const int gw = obid() * NWAVES + wave, ngw = gridDim.x * NWAVES;
    f32x4 gv[4];
#pragma unroll
    for (int j = 0; j < 4; ++j) gv[j] = ((const f32x4*)g)[lane + 64 * j];
    for (int row = gw; row < T; row += ngw) {
        const f32x4* xr = (const f32x4*)(X + (size_t)row * DM) + lane; f32x4 v[4]; float s = 0.f;
#pragma unroll
        for (int j = 0; j < 4; ++j) { v[j] = xr[64 * j]; s += (v[j].x * v[j].x + v[j].y * v[j].y) + (v[j].z * v[j].z + v[j].w * v[j].w); }
        const float rstd = rsqrtf(wave_sum(s, lane) * (1.f / DM) + EPS);
        u32x2* o = (u32x2*)(XN + (size_t)row * DM) + lane;
#pragma unroll
        for (int j = 0; j < 4; ++j) { u32x2 w; w.x = pk2(v[j].x * rstd * gv[j].x, v[j].y * rstd * gv[j].y); w.y = pk2(v[j].z * rstd * gv[j].z, v[j].w * rstd * gv[j].w); o[64 * j] = w; }
    }
}
__device__ __forceinline__ void final_norm_phase(float* out, const bf16* XB, const float* g, const float* ss, int wave, int lane) {
    const int gw = obid() * NWAVES + wave, ngw = gridDim.x * NWAVES;
    f32x4 gv[4];
#pragma unroll
    for (int j = 0; j < 4; ++j) gv[j] = ((const f32x4*)g)[lane + 64 * j];
#pragma unroll 4
    for (int row = gw; row < T; row += ngw) {
        const u32x2* xr = (const u32x2*)(XB + (size_t)row * DM) + lane; f32x4* orow = (f32x4*)(out + (size_t)row * DM) + lane; u32x2 v[4];
#pragma unroll
        for (int j = 0; j < 4; ++j) v[j] = xr[64 * j];
        const float rstd = row_rstd(ss, row);
#pragma unroll
        for (int j = 0; j < 4; ++j) { const f32x4 x = {__uint_as_float(v[j].x << 16), __uint_as_float(v[j].x & 0xffff0000u), __uint_as_float(v[j].y << 16), __uint_as_float(v[j].y & 0xffff0000u)};
            orow[64 * j] = x * rstd * gv[j]; }
    }
}
__device__ __forceinline__ void mla_prep_phase(const bf16* P, bf16* CQN, bf16* CKVN, bf16* KPE, const float* ropeC, const float* ropeS, int wave, int lane) {
    const int gw = obid() * NWAVES + wave, ngw = gridDim.x * NWAVES;
#pragma unroll 4
    for (int row = gw; row < T; row += ngw) {
        const bf16* pr = P + (size_t)row * EV_INP;
        u32x2 q[3]; float f[12]; float s = 0.f;
#pragma unroll
        for (int j = 0; j < 3; ++j) { q[j] = *((const u32x2*)(pr + 1536 + 256 * j) + lane);
            f[4 * j] = __uint_as_float(q[j].x << 16); f[4 * j + 1] = __uint_as_float(q[j].x & 0xffff0000u); f[4 * j + 2] = __uint_as_float(q[j].y << 16); f[4 * j + 3] = __uint_as_float(q[j].y & 0xffff0000u); }
#pragma unroll
        for (int i = 0; i < 12; ++i) s += f[i] * f[i];
        const float rq = rsqrtf(wave_sum(s, lane) * (1.f / 768.f) + EPS);
#pragma unroll
        for (int j = 0; j < 3; ++j) { u32x2 w; w.x = pk2(f[4 * j] * rq, f[4 * j + 1] * rq); w.y = pk2(f[4 * j + 2] * rq, f[4 * j + 3] * rq); *((u32x2*)(CQN + (size_t)row * 768 + 256 * j) + lane) = w; }
        const u32x2 kv = *((const u32x2*)(pr + 2304) + lane);
        const float k0 = __uint_as_float(kv.x << 16), k1 = __uint_as_float(kv.x & 0xffff0000u), k2 = __uint_as_float(kv.y << 16), k3 = __uint_as_float(kv.y & 0xffff0000u);
        const float rk = rsqrtf(wave_sum((k0 * k0 + k1 * k1) + (k2 * k2 + k3 * k3), lane) * (1.f / 256.f) + EPS);
        { u32x2 w; w.x = pk2(k0 * rk, k1 * rk); w.y = pk2(k2 * rk, k3 * rk); *((u32x2*)(CKVN + (size_t)row * 256) + lane) = w; }
        if (lane < 16) { const int pos = row & (SEQ - 1); const float c = ropeC[pos * 16 + lane], sn = ropeS[pos * 16 + lane];
            const float x1 = bf2f(pr[2560 + lane]), x2 = bf2f(pr[2560 + 16 + lane]);
            KPE[(size_t)row * 32 + lane] = (bf16)(pk2(x1 * c - x2 * sn, 0.f) & 0xffffu); KPE[(size_t)row * 32 + 16 + lane] = (bf16)(pk2(x1 * sn + x2 * c, 0.f) & 0xffffu); }
    }
}

template <int NS, int RSV> __device__ __forceinline__ void pv_acc(f32x16 (&o)[2], const bf16x8 (&pb)[NS], const LAS char* vt, int lane) {
    const int g = lane >> 4, hi = g >> 1;
    const int swz = (lane >> 3) & 1;
    const LAS char* base = vt + (4 * hi + ((lane & 15) >> 2)) * RSV + (16 * (g & 1) + 4 * (lane & 3)) * 2;
    const LAS char* bsel[2] = {base + swz * 64, base + (1 - swz) * 64};
#pragma unroll
    for (int db = 0; db < 2; ++db)
#pragma unroll
        for (int s = 0; s < NS; ++s) {
            const s16x4 lo = vtr(bsel[db] + (16 * s) * RSV), h4 = vtr(bsel[db] + (16 * s + 8) * RSV);
            const bf16x8 vf = {lo[0], lo[1], lo[2], lo[3], h4[0], h4[1], h4[2], h4[3]};
            o[db] = MFMA32(vf, pb[s], o[db]);
        }
}
template <int NS, int RSV> __device__ __forceinline__ void pv_acc_batched(f32x16 (&o)[2], const bf16x8 (&pb)[NS], const LAS char* vt, int lane) {
    const int g = lane >> 4, hi = g >> 1; const int swz = (lane >> 3) & 1;
    const LAS char* base = vt + (4 * hi + ((lane & 15) >> 2)) * RSV + (16 * (g & 1) + 4 * (lane & 3)) * 2;
    const LAS char* bsel[2] = {base + swz * 64, base + (1 - swz) * 64};
#pragma unroll
    for (int db = 0; db < 2; ++db) {
        bf16x8 vf[NS];
        __builtin_amdgcn_sched_barrier(0);
#pragma unroll
        for (int s = 0; s < NS; ++s) { const s16x4 lo = vtr(bsel[db] + (16 * s) * RSV), h4 = vtr(bsel[db] + (16 * s + 8) * RSV);
            vf[s] = (bf16x8){lo[0], lo[1], lo[2], lo[3], h4[0], h4[1], h4[2], h4[3]}; }
        __builtin_amdgcn_sched_barrier(0);
#pragma unroll
        for (int s = 0; s < NS; ++s) o[db] = MFMA32(vf[s], pb[s], o[db]);
    }
    __builtin_amdgcn_sched_barrier(0);
}
template <int NT> __device__ __forceinline__ void softmax_step(f32x16 (&s)[NT], float& m, float& l, f32x16 (&o)[2], bf16x8 (&pb)[2 * NT], int lane) {
    float tm = s[0][0];
#pragma unroll
    for (int t = 0; t < NT; ++t)
#pragma unroll
        for (int r = 0; r < 16; ++r) tm = fmaxf(tm, s[t][r]);
    tm = fmaxf(tm, shx(tm, 32, lane));
    if (__any(tm > m + 8.0f)) {
        const float mn = fmaxf(m, tm), alpha = fexp2(m - mn); m = mn; l *= alpha;
#pragma unroll
        for (int r = 0; r < 16; ++r) { o[0][r] *= alpha; o[1][r] *= alpha; }
    }
    float ps = 0.f;
#pragma unroll
    for (int t = 0; t < NT; ++t)
#pragma unroll
        for (int r = 0; r < 16; ++r) { s[t][r] = fexp2(s[t][r] - m); ps += s[t][r]; }
    l += ps;
#pragma unroll
    for (int t = 0; t < NT; ++t) { pb[2 * t] = pack8(s[t], 0); pb[2 * t + 1] = pack8(s[t], 1); }
}
__device__ __forceinline__ void store_o(const f32x16 (&o)[2], float inv, bf16* dst, int hi) {
#pragma unroll
    for (int db = 0; db < 2; ++db)
#pragma unroll
        for (int g4 = 0; g4 < 4; ++g4) { u32x2 w; w.x = pk2(o[db][4 * g4] * inv, o[db][4 * g4 + 1] * inv); w.y = pk2(o[db][4 * g4 + 2] * inv, o[db][4 * g4 + 3] * inv);
            *(u32x2*)(dst + 32 * db + 8 * g4 + 4 * hi) = w; }
}

constexpr int MLA_KRS = 208, MLA_KB = 64 * MLA_KRS, MLA_VB = 64 * 128, MLA_SLOT = MLA_KB + MLA_VB;
constexpr float MLA_THR = 8.0f;
constexpr int MLA_NS = 5;
__device__ __forceinline__ void glds16s(const void* sbase, unsigned voff, unsigned lds_dst) { unsigned keep;
    asm volatile("s_mov_b32 %0, m0\n\ts_mov_b32 m0, %3\n\ts_nop 0\n\tglobal_load_lds_dwordx4 %1, %2\n\ts_mov_b32 m0, %0" : "=&s"(keep) : "v"(voff), "s"(sbase), "s"(lds_dst) : "memory"); }
__device__ __forceinline__ void glds16(const void* gsrc, unsigned lds_dst) { unsigned keep;
    asm volatile("s_mov_b32 %0, m0\n\ts_mov_b32 m0, %2\n\ts_nop 0\n\tglobal_load_lds_dwordx4 %1, off\n\ts_mov_b32 m0, %0" : "=&s"(keep) : "v"(gsrc), "s"(lds_dst) : "memory"); }
__device__ __forceinline__ float fadd_s(float a, float b) { float r; asm("v_add_f32_e32 %0, %1, %2" : "=v"(r) : "v"(a), "v"(b)); return r; }
__device__ __forceinline__ float fsub_s(float a, float b) { float r; asm("v_sub_f32_e32 %0, %1, %2" : "=v"(r) : "v"(a), "v"(b)); return r; }
__device__ __forceinline__ void mla_qk(f32x16 (&s)[2], const LAS char* kslot, const bf16x8 (&qf)[6], int r32, int hi) {
    const LAS char* kb = kslot + r32 * MLA_KRS + 16 * hi;
#pragma unroll
    for (int d0 = 0; d0 < 6; ++d0) { const bf16x8 k0 = *(const LAS bf16x8*)(kb + 32 * d0), k1 = *(const LAS bf16x8*)(kb + 32 * MLA_KRS + 32 * d0);
        if (d0 == 0) { s[0] = MFMA32(k0, qf[0], (f32x16){}); s[1] = MFMA32(k1, qf[0], (f32x16){}); }
        else { s[0] = MFMA32(k0, qf[d0], s[0]); s[1] = MFMA32(k1, qf[d0], s[1]); } }
}
__device__ __forceinline__ void mla_softmax(f32x16 (&s)[2], float& m, float& l, f32x16 (&o)[2], bf16x8 (&pb)[4], int lane) {
    float ps0 = 0.f, ps1 = 0.f;
#pragma unroll
    for (int r = 0; r < 16; ++r) { s[0][r] = fexp2(fsub_s(s[0][r], m)); s[1][r] = fexp2(fsub_s(s[1][r], m)); }
#pragma unroll
    for (int r = 0; r < 16; ++r) { ps0 = fadd_s(ps0, s[0][r]); ps1 = fadd_s(ps1, s[1][r]); }
    float ps = fadd_s(ps0, ps1);
    if (__any(ps > 1048576.f)) {
        const float psm = fmaxf(ps, shx(ps, 32, lane)); const float dl = psm > 1048576.f ? __log2f(psm) : 0.f, f = fexp2(-dl);
        m += dl; l *= f; ps *= f;
#pragma unroll
        for (int r = 0; r < 16; ++r) { s[0][r] *= f; s[1][r] *= f; o[0][r] *= f; o[1][r] *= f; }
    }
    l += ps;
    pb[0] = pack8(s[0], 0); pb[1] = pack8(s[0], 1); pb[2] = pack8(s[1], 0); pb[3] = pack8(s[1], 1);
}
__device__ __forceinline__ void mla_unit(int b, int h, int qb, const bf16* P, const bf16* KV, const bf16* KPE, const float* ropeC, const float* ropeS, bf16* MIX, LAS char* lds, int wave, int lane) {
    const int tid = otid(), r32 = lane & 31, hi = lane >> 5;
    const int pos = qb * 256 + wave * 32 + r32; const size_t row = (size_t)b * SEQ + pos;
    bf16x8 qf[6];
    { const bf16* qp = P + row * EV_INP + 1536 + h * 96 + 8 * hi;
#pragma unroll
      for (int d0 = 0; d0 < 6; ++d0) qf[d0] = *(const bf16x8*)(qp + 16 * d0);
      bf16x8 x1 = qf[4], x2 = qf[5]; u32x4 o1, o2; float r1[8], r2[8];
#pragma unroll
      for (int j = 0; j < 8; ++j) { const float c = ropeC[pos * 16 + 8 * hi + j], sn = ropeS[pos * 16 + 8 * hi + j]; const float a1 = bf2f((unsigned short)x1[j]), a2 = bf2f((unsigned short)x2[j]); r1[j] = a1 * c - a2 * sn; r2[j] = a1 * sn + a2 * c; }
      o1.x = pk2(r1[0], r1[1]); o1.y = pk2(r1[2], r1[3]); o1.z = pk2(r1[4], r1[5]); o1.w = pk2(r1[6], r1[7]);
      o2.x = pk2(r2[0], r2[1]); o2.y = pk2(r2[2], r2[3]); o2.z = pk2(r2[4], r2[5]); o2.w = pk2(r2[6], r2[7]);
      qf[4] = __builtin_bit_cast(bf16x8, o1); qf[5] = __builtin_bit_cast(bf16x8, o2); }
    asm volatile("s_waitcnt vmcnt(0)" ::: "memory");
    const unsigned ldsb = (unsigned)(size_t)lds;
    const unsigned pe_base = (unsigned)((const char*)KPE - (const char*)KV);
    unsigned koff0, koff1, kstr0, kstr1, kd0, kd1;
    { const int p0 = wave, p1 = (wave + 8 < 13) ? wave + 8 : wave;
      { const int sl = p0 * 64 + lane, rw = sl / 13, c = sl - rw * 13;
        if (c >= 8 && c < 12) { koff0 = pe_base + (unsigned)(((b * SEQ + rw) * 32 + 8 * (c - 8)) * 2); kstr0 = 64 * 32 * 2; }
        else { koff0 = (unsigned)(((b * SEQ + rw) * 1024 + h * 128 + 8 * (c == 12 ? 0 : c)) * 2); kstr0 = 64 * 1024 * 2; } kd0 = p0 * 1024; }
      { const int sl = p1 * 64 + lane, rw = sl / 13, c = sl - rw * 13;
        if (c >= 8 && c < 12) { koff1 = pe_base + (unsigned)(((b * SEQ + rw) * 32 + 8 * (c - 8)) * 2); kstr1 = 64 * 32 * 2; }
        else { koff1 = (unsigned)(((b * SEQ + rw) * 1024 + h * 128 + 8 * (c == 12 ? 0 : c)) * 2); kstr1 = 64 * 1024 * 2; } kd1 = p1 * 1024; } }
    unsigned voff; { const int sl = wave * 64 + lane, rw = sl >> 3, c = (sl & 7) ^ ((rw & 2) << 1); voff = (unsigned)(((b * SEQ + rw) * 1024 + h * 128 + 64 + 8 * c) * 2); }
#define MLA_ISSUE(t, slot) do { const unsigned sb_ = ldsb + (unsigned)(slot) * MLA_SLOT; \
        glds16s(KV, koff0 + (unsigned)(t) * kstr0, (unsigned)__builtin_amdgcn_readfirstlane(sb_ + kd0)); \
        glds16s(KV, koff1 + (unsigned)(t) * kstr1, (unsigned)__builtin_amdgcn_readfirstlane(sb_ + kd1)); \
        glds16s(KV, voff + (unsigned)(t) * (64 * 1024 * 2), (unsigned)__builtin_amdgcn_readfirstlane(sb_ + MLA_KB + wave * 1024)); } while (0)
#define MLA_WAITBAR(N) asm volatile("s_waitcnt vmcnt(" #N ") lgkmcnt(0)\n\ts_barrier" ::: "memory")
    MLA_ISSUE(0, 0); MLA_ISSUE(1, 1); MLA_ISSUE(2, 2); MLA_ISSUE(3, 3);
    MLA_WAITBAR(6);
    float m, l = 0.f; f32x16 o[2]; o[0] = f32x16{}; o[1] = f32x16{};
    f32x16 sa[2], sb[2]; bf16x8 pb[4];
    mla_qk(sa, lds, qf, r32, hi);
    { float tm = sa[0][0];
#pragma unroll
      for (int r = 0; r < 16; ++r) tm = fmaxf(tm, fmaxf(sa[0][r], sa[1][r]));
      m = fmaxf(tm, shx(tm, 32, lane)); }
    int s0 = 0;
#define MLA_STEP(t, SC, SX) do { \
        const int s1 = (s0 == MLA_NS - 1) ? 0 : s0 + 1, s4 = (s0 == 0) ? MLA_NS - 1 : s0 - 1; \
        if ((t) + 4 < 32) MLA_ISSUE((t) + 4, s4); \
        const LAS char* kn_slot = lds + s1 * MLA_SLOT; \
        if (wave < 4) { mla_qk(SX, kn_slot, qf, r32, hi); mla_softmax(SC, m, l, o, pb, lane); } \
        else { mla_softmax(SC, m, l, o, pb, lane); mla_qk(SX, kn_slot, qf, r32, hi); } \
        pv_acc<4, 128>(o, pb, lds + s0 * MLA_SLOT + MLA_KB, lane); \
        s0 = s1; \
        if ((t) + 4 < 32) MLA_WAITBAR(6); else MLA_WAITBAR(0); } while (0)
#pragma unroll 1
    for (int t = 0; t < 32; t += 2) { MLA_STEP(t, sa, sb); MLA_STEP(t + 1, sb, sa); }
#undef MLA_STEP
#undef MLA_ISSUE
#undef MLA_WAITBAR
    { const int l2 = otid() & 63; l += shx(l, 32, l2); const size_t row2 = (size_t)b * SEQ + qb * 256 + wave * 32 + (l2 & 31); store_o(o, frcp(l), MIX + row2 * 1024 + 512 + h * 64, l2 >> 5); }
}

__device__ __forceinline__ void mla_load_q(bf16x8 (&qf)[6], const bf16* P, size_t row, int pos, int h, int hi, const float* ropeC, const float* ropeS) {
    const bf16* qp = P + row * EV_INP + 1536 + h * 96 + 8 * hi;
#pragma unroll
    for (int d0 = 0; d0 < 6; ++d0) qf[d0] = *(const bf16x8*)(qp + 16 * d0);
    bf16x8 x1 = qf[4], x2 = qf[5]; u32x4 o1, o2; float r1[8], r2[8];
#pragma unroll
    for (int j = 0; j < 8; ++j) { const float c = ropeC[pos * 16 + 8 * hi + j], sn = ropeS[pos * 16 + 8 * hi + j]; const float a1 = bf2f((unsigned short)x1[j]), a2 = bf2f((unsigned short)x2[j]); r1[j] = a1 * c - a2 * sn; r2[j] = a1 * sn + a2 * c; }
    o1.x = pk2(r1[0], r1[1]); o1.y = pk2(r1[2], r1[3]); o1.z = pk2(r1[4], r1[5]); o1.w = pk2(r1[6], r1[7]);
    o2.x = pk2(r2[0], r2[1]); o2.y = pk2(r2[2], r2[3]); o2.z = pk2(r2[4], r2[5]); o2.w = pk2(r2[6], r2[7]);
    qf[4] = __builtin_bit_cast(bf16x8, o1); qf[5] = __builtin_bit_cast(bf16x8, o2);
}
__device__ __forceinline__ void mla_unit2(int b, int h, int qb2, const bf16* P, const bf16* KV, const bf16* KPE, const float* ropeC, const float* ropeS, bf16* MIX, LAS char* lds, int wave, int lane) {
    const int r32 = lane & 31, hi = lane >> 5;
    const int posA = qb2 * 512 + wave * 64 + r32, posB = posA + 32;
    bf16x8 qfA[6], qfB[6];
    mla_load_q(qfA, P, (size_t)b * SEQ + posA, posA, h, hi, ropeC, ropeS);
    mla_load_q(qfB, P, (size_t)b * SEQ + posB, posB, h, hi, ropeC, ropeS);
    asm volatile("s_waitcnt vmcnt(0)" ::: "memory");
    const unsigned ldsb = (unsigned)(size_t)lds;
    const unsigned pe_base = (unsigned)((const char*)KPE - (const char*)KV);
    unsigned koff0, koff1, kstr0, kstr1, kd0, kd1;
    { const int p0 = wave, p1 = (wave + 8 < 13) ? wave + 8 : wave;
      { const int sl = p0 * 64 + lane, rw = sl / 13, c = sl - rw * 13;
        if (c >= 8 && c < 12) { koff0 = pe_base + (unsigned)(((b * SEQ + rw) * 32 + 8 * (c - 8)) * 2); kstr0 = 64 * 32 * 2; }
        else { koff0 = (unsigned)(((b * SEQ + rw) * 1024 + h * 128 + 8 * (c == 12 ? 0 : c)) * 2); kstr0 = 64 * 1024 * 2; } kd0 = p0 * 1024; }
      { const int sl = p1 * 64 + lane, rw = sl / 13, c = sl - rw * 13;
        if (c >= 8 && c < 12) { koff1 = pe_base + (unsigned)(((b * SEQ + rw) * 32 + 8 * (c - 8)) * 2); kstr1 = 64 * 32 * 2; }
        else { koff1 = (unsigned)(((b * SEQ + rw) * 1024 + h * 128 + 8 * (c == 12 ? 0 : c)) * 2); kstr1 = 64 * 1024 * 2; } kd1 = p1 * 1024; } }
    unsigned voff; { const int sl = wave * 64 + lane, rw = sl >> 3, c = (sl & 7) ^ ((rw & 2) << 1); voff = (unsigned)(((b * SEQ + rw) * 1024 + h * 128 + 64 + 8 * c) * 2); }
#define MLA_ISSUE(t, slot) do { const unsigned sb_ = ldsb + (unsigned)(slot) * MLA_SLOT; \
        glds16s(KV, koff0 + (unsigned)(t) * kstr0, (unsigned)__builtin_amdgcn_readfirstlane(sb_ + kd0)); \
        glds16s(KV, koff1 + (unsigned)(t) * kstr1, (unsigned)__builtin_amdgcn_readfirstlane(sb_ + kd1)); \
        glds16s(KV, voff + (unsigned)(t) * (64 * 1024 * 2), (unsigned)__builtin_amdgcn_readfirstlane(sb_ + MLA_KB + wave * 1024)); } while (0)
#define MLA_WAITBAR(N) asm volatile("s_waitcnt vmcnt(" #N ") lgkmcnt(0)\n\ts_barrier" ::: "memory")
    MLA_ISSUE(0, 0); MLA_ISSUE(1, 1); MLA_ISSUE(2, 2); MLA_ISSUE(3, 3);
    MLA_WAITBAR(6);
    float mA = 0.f, lA = 0.f, mB = 0.f, lB = 0.f; f32x16 oA[2], oB[2]; oA[0] = f32x16{}; oA[1] = f32x16{}; oB[0] = f32x16{}; oB[1] = f32x16{};
    int s0 = 0;
    const int g = lane >> 4, swz = (lane >> 3) & 1;
#pragma unroll 1
    for (int t = 0; t < 32; ++t) {
        const int s1 = (s0 == MLA_NS - 1) ? 0 : s0 + 1, s4 = (s0 == 0) ? MLA_NS - 1 : s0 - 1;
        if (t + 4 < 32) MLA_ISSUE(t + 4, s4);
        const LAS char* kb = lds + s0 * MLA_SLOT + r32 * MLA_KRS + 16 * hi;
        f32x16 sA[2], sB[2];
#pragma unroll
        for (int d0 = 0; d0 < 6; ++d0) { const bf16x8 k0 = *(const LAS bf16x8*)(kb + 32 * d0), k1 = *(const LAS bf16x8*)(kb + 32 * MLA_KRS + 32 * d0);
            if (d0 == 0) { sA[0] = MFMA32(k0, qfA[0], (f32x16){}); sA[1] = MFMA32(k1, qfA[0], (f32x16){}); sB[0] = MFMA32(k0, qfB[0], (f32x16){}); sB[1] = MFMA32(k1, qfB[0], (f32x16){}); }
            else { sA[0] = MFMA32(k0, qfA[d0], sA[0]); sA[1] = MFMA32(k1, qfA[d0], sA[1]); sB[0] = MFMA32(k0, qfB[d0], sB[0]); sB[1] = MFMA32(k1, qfB[d0], sB[1]); } }
        if (t == 0) {
            float ta = sA[0][0], tb = sB[0][0];
#pragma unroll
            for (int r = 0; r < 16; ++r) { ta = fmaxf(ta, fmaxf(sA[0][r], sA[1][r])); tb = fmaxf(tb, fmaxf(sB[0][r], sB[1][r])); }
            mA = fmaxf(ta, shx(ta, 32, lane)); mB = fmaxf(tb, shx(tb, 32, lane)); }
        bf16x8 pbA[4], pbB[4];
        asm volatile("s_nop 15\n\ts_nop 7" : "+v"(sA[0]), "+v"(sA[1]), "+v"(sB[0]), "+v"(sB[1]));
        mla_softmax(sA, mA, lA, oA, pbA, lane);
        mla_softmax(sB, mB, lB, oB, pbB, lane);
        { const LAS char* vt = lds + s0 * MLA_SLOT + MLA_KB;
          const LAS char* base = vt + (4 * (g >> 1) + ((lane & 15) >> 2)) * 128 + (16 * (g & 1) + 4 * (lane & 3)) * 2;
          const LAS char* bsel[2] = {base + swz * 64, base + (1 - swz) * 64};
#pragma unroll
          for (int s = 0; s < 4; ++s)
#pragma unroll
              for (int db = 0; db < 2; ++db) { const s16x4 lo = vtr(bsel[db] + (16 * s) * 128), h4 = vtr(bsel[db] + (16 * s + 8) * 128);
                  const bf16x8 vf = {lo[0], lo[1], lo[2], lo[3], h4[0], h4[1], h4[2], h4[3]};
                  oA[db] = MFMA32(vf, pbA[s], oA[db]); oB[db] = MFMA32(vf, pbB[s], oB[db]); } }
        s0 = s1;
        if (t + 4 < 32) MLA_WAITBAR(6); else MLA_WAITBAR(0);
    }
#undef MLA_ISSUE
#undef MLA_WAITBAR
    { const int l2 = otid() & 63; const int h2 = l2 >> 5; lA += shx(lA, 32, l2); lB += shx(lB, 32, l2);
      const size_t rowA = (size_t)b * SEQ + qb2 * 512 + wave * 64 + (l2 & 31);
      store_o(oA, frcp(lA), MIX + rowA * 1024 + 512 + h * 64, h2); store_o(oB, frcp(lB), MIX + (rowA + 32) * 1024 + 512 + h * 64, h2); }
}

__device__ __forceinline__ float t5_bias_val(const float* t5, int h, int rel) {
    const int n = rel < 0 ? -rel : rel; int bk;
    if (n < 8) bk = n; else bk = 8 + (n >= 15) + (n >= 27) + (n >= 50) + (n >= 91) + (n >= 166) + (n >= 305) + (n >= 559);
    if (rel > 0) bk += 16;
    return t5[bk * 8 + h] * LOG2E;
}
__device__ __forceinline__ void aattn_task(int b, int h, int br, int dil, int r, int i0, const bf16* P, const LAS float* biasT, LAS char* vt, bf16* OB, int ldo, float* LSE, int lane) {
    const int r32 = lane & 31, hi = lane >> 5; const int L = SEQ / dil;
    const size_t qtok = (size_t)b * SEQ + (size_t)(i0 + r32) * dil + r;
    bf16x8 qf[4];
    { const bf16* qp = P + qtok * EV_INP + h * 64 + 8 * hi;
#pragma unroll
      for (int d0 = 0; d0 < 4; ++d0) qf[d0] = *(const bf16x8*)(qp + 16 * d0); }
    float m = NEGBIG, l = 0.f; f32x16 o[2]; o[0] = f32x16{}; o[1] = f32x16{};
    int list = 0, n = 0;
#pragma unroll
    for (int it = 0; it < 5; ++it) { const int kt = (it == 0) ? 2 : (it <= 2 ? it - 1 : it); const int kb_ = i0 - 64 + 32 * kt; if (kb_ + 31 >= 0 && kb_ < L) { list |= kt << (3 * n); ++n; } }
    bf16x8 kfN[4]; u32x4 vvN[4];
#define AA_LOAD(kt_) do { const int kbase_ = i0 - 64 + 32 * (kt_); int kc_ = kbase_ + r32; kc_ = kc_ < 0 ? 0 : (kc_ >= L ? L - 1 : kc_); \
        const bf16* kp_ = P + ((size_t)b * SEQ + (size_t)kc_ * dil + r) * EV_INP + 512 + h * 64 + 8 * hi; \
        _Pragma("unroll") for (int d0 = 0; d0 < 4; ++d0) kfN[d0] = *(const bf16x8*)(kp_ + 16 * d0); \
        _Pragma("unroll") for (int i = 0; i < 4; ++i) { const int c = lane + 64 * i, kk = c >> 3; int kx = kbase_ + kk; kx = kx < 0 ? 0 : (kx >= L ? L - 1 : kx); \
            vvN[i] = *(const u32x4*)(P + ((size_t)b * SEQ + (size_t)kx * dil + r) * EV_INP + 1024 + h * 64 + 8 * (c & 7)); } } while (0)
    AA_LOAD(list & 7);
#pragma unroll 1
    for (int it = 0; it < n; ++it) {
        const int kt = (list >> (3 * it)) & 7; const int kbase = i0 - 64 + 32 * kt;
        bf16x8 kf[4]; u32x4 vv[4];
#pragma unroll
        for (int i = 0; i < 4; ++i) { kf[i] = kfN[i]; vv[i] = vvN[i]; }
        if (it + 1 < n) AA_LOAD((list >> (3 * (it + 1))) & 7);
#pragma unroll
        for (int i = 0; i < 4; ++i) { const int c = lane + 64 * i; *(LAS u32x4*)(vt + (c >> 3) * 128 + (((c & 7) ^ (((c >> 3) & 2) << 1)) * 16)) = vv[i]; }
        f32x16 s[1]; s[0] = f32x16{};
#pragma unroll
        for (int d0 = 0; d0 < 4; ++d0) s[0] = MFMA32(kf[d0], qf[d0], s[0]);
        { const LAS float* bt = biasT + (32 * kt + 32 - r32 + 4 * hi);
          if (kbase >= 0 && kbase + 31 < L) {
#pragma unroll
              for (int rr = 0; rr < 16; ++rr) s[0][rr] += bt[(rr & 3) + 8 * (rr >> 2)];
          } else {
#pragma unroll
              for (int rr = 0; rr < 16; ++rr) { const int kidx = kbase + crow(rr, hi); s[0][rr] = (kidx >= 0 && kidx < L) ? s[0][rr] + bt[(rr & 3) + 8 * (rr >> 2)] : NEGBIG; }
          } }
        bf16x8 pb[2];
        softmax_step<1>(s, m, l, o, pb, lane);
        pv_acc<2, 128>(o, pb, vt, lane);
    }
#undef AA_LOAD
    l += shx(l, 32, lane);
    store_o(o, frcp(l), OB + qtok * ldo + h * 64, hi);
    if (hi == 0) LSE[((size_t)br * T + qtok) * 8 + h] = m + __log2f(l);
}
constexpr int AK_RS = 144;
__device__ __forceinline__ void aattn_task_lds(int b, int h, int br, int dil, int r, int i0, int lrow0, const bf16* P, const LAS float* biasT, const LAS char* Kl, const LAS char* Vl, bf16* OB, int ldo, const bf16* OB1r, float* LSE, int lane) {
    const int r32 = lane & 31, hi = lane >> 5; const int L = SEQ / dil;
    const size_t qtok = (size_t)b * SEQ + (size_t)(i0 + r32) * dil + r;
    bf16x8 qf[4];
    { const bf16* qp = P + qtok * EV_INP + h * 64 + 8 * hi;
#pragma unroll
      for (int d0 = 0; d0 < 4; ++d0) qf[d0] = *(const bf16x8*)(qp + 16 * d0); }
    float m = NEGBIG, l = 0.f; f32x16 o[2]; o[0] = f32x16{}; o[1] = f32x16{};
#pragma unroll 1
    for (int it = 0; it < 5; ++it) {
        const int kt = (it == 0) ? 2 : (it <= 2 ? it - 1 : it); const int kbase = i0 - 64 + 32 * kt;
        if (kbase + 31 < 0 || kbase >= L) continue;
        const int lrow = lrow0 + 32 * kt;
        const LAS char* kp = Kl + (lrow + r32) * AK_RS + 16 * hi;
        f32x16 s[1]; s[0] = f32x16{};
#pragma unroll
        for (int d0 = 0; d0 < 4; ++d0) { const bf16x8 kf = *(const LAS bf16x8*)(kp + 32 * d0); s[0] = MFMA32(kf, qf[d0], s[0]); }
        { const LAS float* bt = biasT + (32 * kt + 32 - r32 + 4 * hi);
          if (kbase >= 0 && kbase + 31 < L) {
#pragma unroll
              for (int rr = 0; rr < 16; ++rr) s[0][rr] += bt[(rr & 3) + 8 * (rr >> 2)];
          } else {
#pragma unroll
              for (int rr = 0; rr < 16; ++rr) { const int kidx = kbase + crow(rr, hi); s[0][rr] = (kidx >= 0 && kidx < L) ? s[0][rr] + bt[(rr & 3) + 8 * (rr >> 2)] : NEGBIG; }
          } }
        bf16x8 pb[2];
        softmax_step<1>(s, m, l, o, pb, lane);
        pv_acc<2, 128>(o, pb, Vl + lrow * 128, lane);
    }
    l += shx(l, 32, lane);
    if (br < 2) {
        store_o(o, frcp(l), OB + qtok * ldo + h * 64, hi);
        if (hi == 0) LSE[((size_t)br * T + qtok) * 8 + h] = m + __log2f(l);
    } else {
        const float l3 = m + __log2f(l), l1 = LSE[((size_t)0 * T + qtok) * 8 + h], l2 = LSE[((size_t)1 * T + qtok) * 8 + h];
        const float mx = fmaxf(l3, fmaxf(l1, l2)); float w1 = fexp2(l1 - mx), w2 = fexp2(l2 - mx), w3 = fexp2(l3 - mx); const float inv = frcp(w1 + w2 + w3); w1 *= inv; w2 *= inv; w3 *= inv * frcp(l);
        bf16* dst = OB + qtok * ldo + h * 64; const bf16* p2 = OB1r + qtok * 512 + h * 64;
        u32x2 av[2][4], bv[2][4];
#pragma unroll
        for (int db = 0; db < 2; ++db)
#pragma unroll
            for (int g4 = 0; g4 < 4; ++g4) { const int off = 32 * db + 8 * g4 + 4 * hi; av[db][g4] = *(const u32x2*)(dst + off); bv[db][g4] = *(const u32x2*)(p2 + off); }
#pragma unroll
        for (int db = 0; db < 2; ++db)
#pragma unroll
            for (int g4 = 0; g4 < 4; ++g4) { const int off = 32 * db + 8 * g4 + 4 * hi; const u32x2 a = av[db][g4], bq = bv[db][g4];
                const float e0 = w1 * __uint_as_float(a.x << 16) + w2 * __uint_as_float(bq.x << 16) + w3 * o[db][4 * g4];
                const float e1 = w1 * __uint_as_float(a.x & 0xffff0000u) + w2 * __uint_as_float(bq.x & 0xffff0000u) + w3 * o[db][4 * g4 + 1];
                const float e2 = w1 * __uint_as_float(a.y << 16) + w2 * __uint_as_float(bq.y << 16) + w3 * o[db][4 * g4 + 2];
                const float e3 = w1 * __uint_as_float(a.y & 0xffff0000u) + w2 * __uint_as_float(bq.y & 0xffff0000u) + w3 * o[db][4 * g4 + 3];
                u32x2 w; w.x = pk2(e0, e1); w.y = pk2(e2, e3); *(u32x2*)(dst + off) = w; }
    }
}
__device__ __forceinline__ void aattn_unit(int b, int h, int sb, const bf16* P, const float* t5, bf16* MIX, bf16* OB1, bf16* OB2, float* LSE, LAS char* lds, int wave, int lane) {
    LAS float* biasT = (LAS float*)lds;
    LAS char* Kl = lds + 4096; LAS char* Vl = Kl + 384 * AK_RS;
    for (int i = otid(); i < 3 * 192; i += NTHREADS) { const int br = i / 192, j = i % 192 - 96; const int dil = br == 0 ? 1 : (br == 1 ? 4 : 16); biasT[i] = (j >= -64 && j <= 64) ? t5_bias_val(t5, h, j * dil) : NEGBIG; }
#pragma unroll 1
    for (int g = 0; g < 14; ++g) {
        int br, dil, r0, nres, kb0, q0;
        if (g < 4) { br = 0; dil = 1; r0 = 0; nres = 1; q0 = 1024 * sb + 256 * g; kb0 = q0 - 64; }
        else if (g < 8) { br = 1; dil = 4; r0 = g - 4; nres = 1; q0 = 256 * sb; kb0 = q0 - 64; }
        else { br = 2; dil = 16; r0 = 3 * (g - 8); nres = (g == 13) ? 1 : 3; q0 = 64 * sb; kb0 = 0; }
        const int L = SEQ / dil; const int nrows = (br == 2) ? 128 * nres : 384;
        __syncthreads();
#pragma unroll 1
        for (int hb = 0; hb < 2; ++hb) { const int tid = otid(); u32x4 st[6];
#pragma unroll
          for (int i = 0; i < 6; ++i) { const int c = tid + NTHREADS * (6 * hb + i), row = c >> 4, part = c & 15;
              int kidx, rr_; if (br == 2) { rr_ = r0 + (row >> 7); kidx = row & 127; } else { rr_ = r0; kidx = kb0 + row; kidx = kidx < 0 ? 0 : (kidx >= L ? L - 1 : kidx); }
              const bf16* src = P + ((size_t)b * SEQ + (size_t)kidx * dil + rr_) * EV_INP + 512 + h * 64 + (part < 8 ? 8 * part : 512 + 8 * (part - 8));
              st[i] = (row < nrows) ? *(const u32x4*)src : (u32x4){0u, 0u, 0u, 0u}; }
#pragma unroll
          for (int i = 0; i < 6; ++i) { const int c = tid + NTHREADS * (6 * hb + i), row = c >> 4, part = c & 15;
              if (part < 8) *(LAS u32x4*)(Kl + row * AK_RS + part * 16) = st[i]; else *(LAS u32x4*)(Vl + row * 128 + (((part - 8) ^ ((row & 2) << 1)) * 16)) = st[i]; } }
        __syncthreads();
        bf16* OB = br == 1 ? OB1 : MIX; const int ldo = br == 1 ? 512 : 1024;
        if (br < 2) aattn_task_lds(b, h, br, dil, r0, q0 + 32 * wave, 32 * wave, P, biasT + br * 192, Kl, Vl, OB, ldo, OB1, LSE, lane);
        else if (wave < 2 * nres) { const int j = wave >> 1, i0 = q0 + 32 * (wave & 1); aattn_task_lds(b, h, br, dil, r0 + j, i0, 128 * j + i0 - 64, P, biasT + br * 192, Kl, Vl, OB, ldo, OB1, LSE, lane); }
    }
    __syncthreads();
}

__device__ __forceinline__ void natten_task(int b, int h, int ip, int cb, const bf16* P, const float* rpb, LAS float* rpbL, LAS char* vt, bf16* MIX, int lane) {
    const int r32 = lane & 31, hi = lane >> 5;
    for (int i = lane; i < 15 * 31; i += 64) rpbL[i] = rpb[h * 465 + i] * LOG2E;
    const int qi = 2 * ip + (r32 >> 4), qc = 16 * cb + (r32 & 15);
    const size_t qtok = (size_t)b * SEQ + qi * 64 + qc;
    bf16x8 qf[4];
    { const bf16* qp = P + qtok * OD_IN + 1024 + h * 64 + 8 * hi;
#pragma unroll
      for (int d0 = 0; d0 < 4; ++d0) qf[d0] = *(const bf16x8*)(qp + 16 * d0); }
    int r0q = qi - 4; r0q = r0q < 0 ? 0 : (r0q > 24 ? 24 : r0q);
    int qs = qc - 8; qs = qs < 0 ? 0 : (qs > 48 ? 48 : qs);
    int kb = 16 * cb - 8; kb = kb < 0 ? 0 : (kb > 32 ? 32 : kb);
    int rlo = 2 * ip - 4; rlo = rlo < 0 ? 0 : (rlo > 24 ? 24 : rlo);
    int rhi = 2 * ip + 1 - 4; rhi = (rhi < 0 ? 0 : (rhi > 24 ? 24 : rhi)) + 7;
    float m = NEGBIG, l = 0.f; f32x16 o[2]; o[0] = f32x16{}; o[1] = f32x16{};
    const int nrow = rhi - rlo + 1;
    bf16x8 kfN[4]; u32x4 vvN[4];
#define NA_ROW(it_) ((it_) == 0 ? 2 * ip : ((rlo + (it_) - 1 >= 2 * ip) ? rlo + (it_) : rlo + (it_) - 1))
#define NA_LOAD(kr_) do { const size_t kt0_ = (size_t)b * SEQ + (kr_) * 64 + kb; const bf16* kp_ = P + (kt0_ + r32) * OD_IN + 1536 + h * 64 + 8 * hi; \
        _Pragma("unroll") for (int d0 = 0; d0 < 4; ++d0) kfN[d0] = *(const bf16x8*)(kp_ + 16 * d0); \
        _Pragma("unroll") for (int i = 0; i < 4; ++i) { const int c = lane + 64 * i; vvN[i] = *(const u32x4*)(P + (kt0_ + (c >> 3)) * OD_IN + 2048 + h * 64 + 8 * (c & 7)); } } while (0)
    NA_LOAD(2 * ip);
#pragma unroll 1
    for (int it = 0; it < nrow; ++it) {
        const int kr = NA_ROW(it);
        bf16x8 kf[4]; u32x4 vv[4];
#pragma unroll
        for (int i = 0; i < 4; ++i) { kf[i] = kfN[i]; vv[i] = vvN[i]; }
        if (it + 1 < nrow) { const int krn = NA_ROW(it + 1); NA_LOAD(krn); }
#pragma unroll
        for (int i = 0; i < 4; ++i) { const int c = lane + 64 * i; *(LAS u32x4*)(vt + (c >> 3) * 128 + (((c & 7) ^ (((c >> 3) & 2) << 1)) * 16)) = vv[i]; }
        f32x16 s[1]; s[0] = f32x16{};
#pragma unroll
        for (int d0 = 0; d0 < 4; ++d0) s[0] = MFMA32(kf[d0], qf[d0], s[0]);
        const bool rowok = (kr >= r0q) && (kr < r0q + 8); const int dr = kr - qi + 7;
#pragma unroll
        for (int rr = 0; rr < 16; ++rr) { const int kcol = kb + crow(rr, hi); const bool valid = rowok && (kcol >= qs) && (kcol < qs + 16);
            int dc = kcol - qc + 15; dc = dc < 0 ? 0 : (dc > 30 ? 30 : dc); const int drc = dr < 0 ? 0 : (dr > 14 ? 14 : dr);
            s[0][rr] = valid ? s[0][rr] + rpbL[drc * 31 + dc] : NEGBIG; }
        bf16x8 pb[2];
        softmax_step<1>(s, m, l, o, pb, lane);
        pv_acc<2, 128>(o, pb, vt, lane);
    }
#undef NA_LOAD
#undef NA_ROW
    l += shx(l, 32, lane);
    store_o(o, frcp(l), MIX + qtok * 1024 + 512 + h * 64, hi);
}

__device__ __forceinline__ void natten_task2(int b, int h, int ipp, int cb, const bf16* P, const float* rpb, LAS float* rpbL, LAS char* vt, bf16* MIX, int lane) {
    const int r32 = lane & 31, hi = lane >> 5;
    for (int i = lane; i < 15 * 31; i += 64) rpbL[i] = rpb[h * 465 + i] * LOG2E;
    const int qiA = 4 * ipp + (r32 >> 4), qiB = qiA + 2, qc = 16 * cb + (r32 & 15);
    const size_t qtokA = (size_t)b * SEQ + qiA * 64 + qc, qtokB = qtokA + 128;
    bf16x8 qfA[4], qfB[4];
    { const bf16* qp = P + qtokA * OD_IN + 1024 + h * 64 + 8 * hi; const bf16* qq = P + qtokB * OD_IN + 1024 + h * 64 + 8 * hi;
#pragma unroll
      for (int d0 = 0; d0 < 4; ++d0) { qfA[d0] = *(const bf16x8*)(qp + 16 * d0); qfB[d0] = *(const bf16x8*)(qq + 16 * d0); } }
    int r0A = qiA - 4; r0A = r0A < 0 ? 0 : (r0A > 24 ? 24 : r0A);
    int r0B = qiB - 4; r0B = r0B < 0 ? 0 : (r0B > 24 ? 24 : r0B);
    int qs = qc - 8; qs = qs < 0 ? 0 : (qs > 48 ? 48 : qs);
    int kb = 16 * cb - 8; kb = kb < 0 ? 0 : (kb > 32 ? 32 : kb);
    int rlo = 4 * ipp - 4; rlo = rlo < 0 ? 0 : (rlo > 24 ? 24 : rlo);
    int rhi = 4 * ipp + 3 - 4; rhi = (rhi < 0 ? 0 : (rhi > 24 ? 24 : rhi)) + 7;
    const int first = 4 * ipp + 1;
    float mA = NEGBIG, lA = 0.f, mB = NEGBIG, lB = 0.f; f32x16 oA[2], oB[2]; oA[0] = f32x16{}; oA[1] = f32x16{}; oB[0] = f32x16{}; oB[1] = f32x16{};
    const int nrow = rhi - rlo + 1;
    bf16x8 kfN[4]; u32x4 vvN[4];
#define NA_ROW(it_) ((it_) == 0 ? first : ((rlo + (it_) - 1 >= first) ? rlo + (it_) : rlo + (it_) - 1))
#define NA_LOAD(kr_) do { const size_t kt0_ = (size_t)b * SEQ + (kr_) * 64 + kb; const bf16* kp_ = P + (kt0_ + r32) * OD_IN + 1536 + h * 64 + 8 * hi; \
        _Pragma("unroll") for (int d0 = 0; d0 < 4; ++d0) kfN[d0] = *(const bf16x8*)(kp_ + 16 * d0); \
        _Pragma("unroll") for (int i = 0; i < 4; ++i) { const int c = lane + 64 * i; vvN[i] = *(const u32x4*)(P + (kt0_ + (c >> 3)) * OD_IN + 2048 + h * 64 + 8 * (c & 7)); } } while (0)
    NA_LOAD(first);
    const int g = lane >> 4, swz = (lane >> 3) & 1;
    const LAS char* vbase = vt + (4 * (g >> 1) + ((lane & 15) >> 2)) * 128 + (16 * (g & 1) + 4 * (lane & 3)) * 2;
#pragma unroll 1
    for (int it = 0; it < nrow; ++it) {
        const int kr = NA_ROW(it);
        bf16x8 kf[4]; u32x4 vv[4];
#pragma unroll
        for (int i = 0; i < 4; ++i) { kf[i] = kfN[i]; vv[i] = vvN[i]; }
        if (it + 1 < nrow) { const int krn = NA_ROW(it + 1); NA_LOAD(krn); }
#pragma unroll
        for (int i = 0; i < 4; ++i) { const int c = lane + 64 * i; *(LAS u32x4*)(vt + (c >> 3) * 128 + (((c & 7) ^ (((c >> 3) & 2) << 1)) * 16)) = vv[i]; }
        f32x16 sA[1], sB[1]; sA[0] = f32x16{}; sB[0] = f32x16{};
#pragma unroll
        for (int d0 = 0; d0 < 4; ++d0) { sA[0] = MFMA32(kf[d0], qfA[d0], sA[0]); sB[0] = MFMA32(kf[d0], qfB[d0], sB[0]); }
        const bool okA = (kr >= r0A) && (kr < r0A + 8), okB = (kr >= r0B) && (kr < r0B + 8);
        int drA = kr - qiA + 7; drA = drA < 0 ? 0 : (drA > 14 ? 14 : drA); int drB = kr - qiB + 7; drB = drB < 0 ? 0 : (drB > 14 ? 14 : drB);
#pragma unroll
        for (int rr = 0; rr < 16; ++rr) { const int kcol = kb + crow(rr, hi); const bool cv = (kcol >= qs) && (kcol < qs + 16);
            int dc = kcol - qc + 15; dc = dc < 0 ? 0 : (dc > 30 ? 30 : dc);
            sA[0][rr] = (okA && cv) ? sA[0][rr] + rpbL[drA * 31 + dc] : NEGBIG; sB[0][rr] = (okB && cv) ? sB[0][rr] + rpbL[drB * 31 + dc] : NEGBIG; }
        bf16x8 pbA[2], pbB[2];
        softmax_step<1>(sA, mA, lA, oA, pbA, lane);
        softmax_step<1>(sB, mB, lB, oB, pbB, lane);
#pragma unroll
        for (int s2 = 0; s2 < 2; ++s2)
#pragma unroll
            for (int db = 0; db < 2; ++db) { const LAS char* bp = vbase + ((db ^ swz) * 64) + (16 * s2) * 128; const s16x4 lo = vtr(bp), h4 = vtr(bp + 8 * 128);
                const bf16x8 vf = {lo[0], lo[1], lo[2], lo[3], h4[0], h4[1], h4[2], h4[3]};
                oA[db] = MFMA32(vf, pbA[s2], oA[db]); oB[db] = MFMA32(vf, pbB[s2], oB[db]); }
    }
#undef NA_LOAD
#undef NA_ROW
    lA += shx(lA, 32, lane); lB += shx(lB, 32, lane);
    store_o(oA, frcp(lA), MIX + qtokA * 1024 + 512 + h * 64, hi); store_o(oB, frcp(lB), MIX + qtokB * 1024 + 512 + h * 64, hi);
}

constexpr int GM_RS = 1040;
__device__ __forceinline__ void gmlp_unit(int chunk, const bf16* __restrict__ P, const float* __restrict__ vgain, const bf16* __restrict__ wsb, const float* __restrict__ bs, bf16* __restrict__ MIX, LAS char* lds, int wave, int lane) {
    const int r32 = lane & 31, hi = lane >> 5; const size_t tok0 = (size_t)chunk * 128;
    { f32x4 g0 = *(const f32x4*)(vgain + 8 * lane), g1 = *(const f32x4*)(vgain + 8 * lane + 4);
#pragma unroll 4
      for (int j = wave * 16; j < wave * 16 + 16; ++j) {
          const u32x4 raw = *(const u32x4*)(P + (tok0 + j) * OD_IN + 512 + 8 * lane); float f[8];
#pragma unroll
          for (int e = 0; e < 4; ++e) { f[2 * e] = gelu_tanh_(__uint_as_float(raw[e] << 16)); f[2 * e + 1] = gelu_tanh_(__uint_as_float(raw[e] & 0xffff0000u)); }
          float s = 0.f;
#pragma unroll
          for (int e = 0; e < 8; ++e) s += f[e];
          const float mu = wave_sum(s, lane) * (1.f / 512.f); float q = 0.f;
#pragma unroll
          for (int e = 0; e < 8; ++e) { f[e] -= mu; q += f[e] * f[e]; }
          const float rstd = rsqrtf(wave_sum(q, lane) * (1.f / 512.f) + EPS);
          u32x4 w; w.x = pk2(f[0] * rstd * g0.x, f[1] * rstd * g0.y); w.y = pk2(f[2] * rstd * g0.z, f[3] * rstd * g0.w); w.z = pk2(f[4] * rstd * g1.x, f[5] * rstd * g1.y); w.w = pk2(f[6] * rstd * g1.z, f[7] * rstd * g1.w);
          *(LAS u32x4*)(lds + j * GM_RS + lane * 16) = w; } }
    __syncthreads();
    const int g = wave; const int gq = lane >> 4, h2 = gq >> 1;
    const bf16* wg = wsb + (size_t)g * 128 * 128;
#pragma unroll 2
    for (int cb4 = 0; cb4 < 8; ++cb4) {
        const int cbk = cb4 >> 2, ib = cb4 & 3;
        f32x16 acc = f32x16{};
        const LAS char* base = lds + (8 * h2 + ((lane & 15) >> 2)) * GM_RS + (64 * g + 32 * cbk + 16 * (gq & 1) + 4 * (lane & 3)) * 2;
        const bf16* ap = wg + (size_t)(32 * ib + r32) * 128 + 8 * hi;
        const int ch = 64 * g + 32 * cbk + r32;
        unsigned short uraw[16]; float bsv[16];
#pragma unroll
        for (int rr = 0; rr < 16; ++rr) { const int i = 32 * ib + crow(rr, hi); uraw[rr] = P[(tok0 + i) * OD_IN + ch]; bsv[rr] = bs[g * 128 + i]; }
#pragma unroll
        for (int s = 0; s < 8; ++s) {
            const s16x4 lo = vtr(base + (16 * s) * GM_RS), h4 = vtr(base + (16 * s + 4) * GM_RS);
            const bf16x8 vf = {lo[0], lo[1], lo[2], lo[3], h4[0], h4[1], h4[2], h4[3]};
            const bf16x8 af = *(const bf16x8*)(ap + 16 * s);
            acc = MFMA32(af, vf, acc);
        }
#pragma unroll
        for (int rr = 0; rr < 16; ++rr) { const int i = 32 * ib + crow(rr, hi);
            const float uu = gelu_tanh_(bf2f(uraw[rr]));
            MIX[(tok0 + i) * 1024 + ch] = (bf16)(pk2(uu * (acc[rr] + bsv[rr]), 0.f) & 0xffffu); }
    }
    __syncthreads();
}

#ifndef REP_ATT
#define REP_ATT 1
#endif
#ifndef REP_SMALL
#define REP_SMALL 1
#endif
#ifndef REP_G14
#define REP_G14 1
#endif
#ifndef REP_A
#define REP_A 1
#endif
#ifndef REP_ODD
#define REP_ODD 1
#endif
#ifndef REP_M
#define REP_M 1
#endif
#ifndef REP_SYNC
#define REP_SYNC 1
#endif
#ifndef EN_PRO
#define EN_PRO 1
#endif
#ifndef EN_NORM
#define EN_NORM 1
#endif
#ifndef EN_PREP
#define EN_PREP 1
#endif
#ifndef EN_AATT
#define EN_AATT 1
#endif
#ifndef EN_MLA
#define EN_MLA 1
#endif
#ifndef EN_GMLP
#define EN_GMLP 1
#endif
#ifndef EN_NAT
#define EN_NAT 1
#endif
#ifndef EN_G1
#define EN_G1 1
#endif
#ifndef EN_G2
#define EN_G2 1
#endif
#ifndef EN_G3
#define EN_G3 1
#endif
#ifndef EN_G4
#define EN_G4 1
#endif
#ifndef EN_G5
#define EN_G5 1
#endif
__global__ void __launch_bounds__(NTHREADS, 2) fwd_kernel(Args a) {
    extern __shared__ __attribute__((aligned(16))) unsigned char lds_raw[];
    LAS unsigned char* lds = (LAS unsigned char*)lds_raw;
    cg::grid_group grid = cg::this_grid();
    if (threadIdx.x < 4) ((LAS unsigned*)(lds + LDS_MISC))[threadIdx.x] = 0u;
    __syncthreads();
    { XcdBarrier xb0 = xcd_barrier_post((unsigned*)(a.ws + WS_BAR), (volatile LAS unsigned*)(lds + LDS_MISC)); (void)xb0; }
    if (a.ph_lo > 1000) grid.sync();
    const int lo = a.ph_lo, hi_ = a.ph_hi;
#pragma unroll 1
    for (int st = lo; st < hi_; ++st) {
        bool sync_after = (st + 1 < hi_);
        const int tid = otid(), lane = tid & 63, wave = __builtin_amdgcn_readfirstlane(tid >> 6);
        ArgsP ap = (ArgsP)__builtin_amdgcn_kernarg_segment_ptr(); asm volatile("" : "+s"(ap));
    unsigned char* ws = ap->ws;
        bf16* Wb = (bf16*)(ws + WS_W);
        bf16* XN = (bf16*)(ws + WS_XN); bf16* PH = (bf16*)(ws + WS_PH); bf16* MIX = (bf16*)(ws + WS_MIX); bf16* KVb = (bf16*)(ws + WS_KV); bf16* KPE = (bf16*)(ws + WS_KPE);
        float* LSE = (float*)(ws + WS_LSE); float* SSA = (float*)(ws + WS_SSA); float* SSB = (float*)(ws + WS_SSB); const float* ropeC = (const float*)(ws + WS_ROPEC); const float* ropeS = (const float*)(ws + WS_ROPES);
        bf16* CQN = MIX; bf16* CKVN = MIX + (size_t)T * 768;   bf16* OB1 = (bf16*)ap->out; bf16* OB2 = OB1 + (size_t)T * 512;
        float* X = ap->out;
        if (st == 0) { for (int rp = 0; rp < REP_SMALL; ++rp) { if (EN_PRO) prologue(ap, lds, wave, lane); } }
        else if (st == 41) { if (EN_NORM) final_norm_phase(ap->out, XN, ap->in[I_FINAL], SSA, wave, lane); }
        else {
            const int layer = (st - 1) / 10, k = (st - 1) % 10, j = layer >> 1; const bool even = (layer & 1) == 0;
            const float* Xin = layer == 0 ? ap->in[I_X] : X;
            if (k == 0 || k == 2 || k == 7 || (!even && (k == 3 || k == 4))) continue;
            if (k == 0) { for (int rp = 0; rp < REP_SMALL; ++rp) { if (EN_NORM) rmsnorm_phase(Xin, ap->in[I_NMIX] + layer * DM, XN, wave, lane); } }
            else if (k == 7) { for (int rp = 0; rp < REP_SMALL; ++rp) { if (EN_NORM) rmsnorm_phase(X, ap->in[I_NFFN] + layer * DM, XN, wave, lane); } }
            else if (k == 2) { for (int rp = 0; rp < REP_SMALL; ++rp) { if (EN_PREP) mla_prep_phase(PH, CQN, CKVN, KPE, ropeC, ropeS, wave, lane); } }
            else if (k == 5) { for (int rp = 0; rp < REP_ATT; ++rp) {
                if (even) {
                    const int bid_ = obid(), G_ = (int)gridDim.x, n_ = (768 - bid_ + G_ - 1) / G_; const bool flip_ = ((bid_ >> 5) & 1) != 0;
                    for (int i_ = 0; i_ < n_; ++i_) { const int u = bid_ + G_ * (flip_ ? n_ - 1 - i_ : i_);
                        if (u < 256) { const int tid2 = otid(), lane = tid2 & 63, wave = __builtin_amdgcn_readfirstlane(tid2 >> 6); if (EN_AATT) aattn_unit(u >> 4, (u >> 1) & 7, u & 1, PH, ap->in[I_T5], MIX, OB1, OB2, LSE, (LAS char*)lds, wave, lane); }
                        else { const int tid3 = otid(), lane = tid3 & 63, wave = __builtin_amdgcn_readfirstlane(tid3 >> 6); const int v = u - 256; const int bh = (v & 7) + 8 * (v >> 5), qb2 = (v >> 3) & 3; if (EN_MLA) mla_unit2(bh >> 3, bh & 7, qb2, PH, KVb, KPE, ropeC, ropeS, MIX, (LAS char*)lds, wave, lane); }
                    }
                } else {
                    for (int u_ = obid(); u_ < 768; u_ += gridDim.x) { const int u = u_;
                        const int tid2 = otid(), lane = tid2 & 63, wave = __builtin_amdgcn_readfirstlane(tid2 >> 6);
                        if (u < 256) { if (EN_GMLP) gmlp_unit(u, PH, ap->in[I_ODVG] + j * 512, Wb + E_WS + (size_t)j * 8 * 128 * 128, ap->in[I_ODBS] + j * 1024, MIX, (LAS char*)lds, wave, lane); }
                        else { const int task = (u - 256) * 8 + wave; const int cb = task & 3, ipp = (task >> 2) & 7, h = (task >> 5) & 7, b = task >> 8;
                            if (EN_NAT) natten_task2(b, h, ipp, cb, PH, ap->in[I_ODRPB] + (size_t)j * 8 * 465, (LAS float*)(lds + wave * 8192 + 4096), (LAS char*)lds + wave * 8192, MIX, lane); }
                    }
                    __syncthreads();
                }
                if (rp + 1 < REP_ATT) { XcdBarrier xbar; xbar.bar = (unsigned*)(ap->ws + WS_BAR); xbar.x = xb_xcc_id(); xbar.st = (volatile LAS unsigned*)(lds + LDS_MISC); xcd_barrier(xbar); }; }
            } else {
                const bf16* A; const bf16* Bt; int N, K; EpiUni E; E.mode = 0; E.O = PH; E.ldc = EV_INP; E.base = X; E.out = X; E.ss_in = nullptr; E.ss_out = SSA; E.xb = XN; E.wsb = ws; E.qmask = 0xFu; E.sinv = 1.f / DM;
                if (k == 1) { A = XN; K = 1024; E.ss_in = SSA; if (even) { Bt = Wb + E_EVIN + (size_t)j * EV_INP * 1024; N = EV_INP; E.ldc = EV_INP; E.mode = 3; } else { Bt = Wb + E_ODIN + (size_t)j * OD_IN * 1024; N = OD_IN; E.ldc = OD_IN; } }
                else if (k == 3) { A = CQN; Bt = Wb + E_UQ + (size_t)j * 768 * 768; N = 768; K = 768; E.O = PH + 1536; E.ldc = EV_INP; E.ss_in = (const float*)(ws + WS_QSS); E.qmask = 7u; E.sinv = 1.f / 768.f; sync_after = false; }
                else if (k == 4) { A = CKVN; Bt = Wb + E_UKV + (size_t)j * 1024 * 256; N = 1024; K = 256; E.O = KVb; E.ldc = 1024; E.ss_in = (const float*)(ws + WS_QSS); E.qmask = 8u; E.sinv = 1.f / 256.f; }
                else if (k == 6) { A = MIX; Bt = Wb + (even ? E_EVOUT : E_ODOUT) + (size_t)j * 1024 * 1024; N = 1024; K = 1024; E.mode = 2; E.base = Xin; E.ss_out = SSB; }
                else if (k == 8) { A = XN; Bt = Wb + E_GU + (size_t)layer * 2 * FF * 1024; N = 2 * FF; K = 1024; E.mode = 1; E.O = PH; E.ss_in = SSB; }
                else { A = PH; Bt = Wb + E_DN + (size_t)layer * 1024 * FF; N = 1024; K = FF; E.mode = 2; }
                for (int rp = 0; rp < ((k == 1 || k == 8) ? REP_G14 : 1); ++rp) { if (rp) { XcdBarrier xbar; xbar.bar = (unsigned*)(ap->ws + WS_BAR); xbar.x = xb_xcc_id(); xbar.st = (volatile LAS unsigned*)(lds + LDS_MISC); xcd_barrier(xbar); };
                if (EN_G1) { pg8::Gemm g{A, Bt, T, N, K}; pg8::StaticOrder S; S.init(T, N, (int)gridDim.x, (int)obid());
                    pg8::gemm_phase<EpiUni, pg8::StaticOrder, true, true>(lds, g, S, E); } }
            }
        }
        if (sync_after) { for (int rp = 0; rp < REP_SYNC; ++rp) { XcdBarrier xbar; xbar.bar = (unsigned*)(ap->ws + WS_BAR); xbar.x = xb_xcc_id(); xbar.st = (volatile LAS unsigned*)(lds + LDS_MISC); xcd_barrier(xbar); }; }
    }
}

extern "C" void kernel_launch(void* const* d_in, const int* in_sizes, int n_in, void* d_out, int out_size, void* d_ws, size_t ws_size, hipStream_t stream) {
    static int grid = 0;
    if (grid == 0) {
        if (n_in != 19 || out_size != T * DM || ws_size < WS_END) { fprintf(stderr, "kernel_launch: unexpected shapes n_in %d out %d ws %zu (need %zu)\n", n_in, out_size, ws_size, (size_t)WS_END); grid = -1; return; }
        int dev = 0, cus = 0, per_cu = 0;
        (void)hipGetDevice(&dev); (void)hipDeviceGetAttribute(&cus, hipDeviceAttributeMultiprocessorCount, dev);
        if (hipFuncSetAttribute((const void*)fwd_kernel, hipFuncAttributeMaxDynamicSharedMemorySize, LDS_BYTES) != hipSuccess) { fprintf(stderr, "kernel_launch: hipFuncSetAttribute failed\n"); grid = -1; return; }
        if (hipOccupancyMaxActiveBlocksPerMultiprocessor(&per_cu, (const void*)fwd_kernel, NTHREADS, LDS_BYTES) != hipSuccess || per_cu < 1) { fprintf(stderr, "kernel_launch: occupancy query gave %d\n", per_cu); per_cu = 1; }
        (void)hipGetLastError();
        grid = cus * 1;
    }
    if (grid < 0) return;
    if (hipMemsetAsync((char*)d_ws + WS_BAR, 0, BAR_BYTES, stream) != hipSuccess) { fprintf(stderr, "kernel_launch: memset failed\n"); return; }
    Args a{};
    for (int i = 0; i < 19; ++i) a.in[i] = (const float*)d_in[i];
    a.out = (float*)d_out; a.ws = (unsigned char*)d_ws; a.ph_lo = 0; a.ph_hi = 42;
    void* args[] = {&a};
    hipError_t e = hipLaunchCooperativeKernel((const void*)fwd_kernel, dim3(grid), dim3(NTHREADS), args, LDS_BYTES, stream);
    if (e != hipSuccess) fprintf(stderr, "kernel_launch: cooperative launch failed: %s (grid %d)\n", hipGetErrorString(e), grid);
}
```
